# Optimizing an MI355X kernel written in HIP

```python
import jax
import jax.numpy as jnp
from jax import lax
import numpy as np

D_MODEL = 1024
BATCH = 32
SEQ = 2048
DEPTH = 1

HEAD_DIM = 64
N_ATTN_HEADS = (D_MODEL // 2) // HEAD_DIM
ATTN_WIDTH = N_ATTN_HEADS * HEAD_DIM
MOBA_BLOCK = 256
MOBA_TOPK = 3
Q_CHUNK = 128
SGU_WIDTH = D_MODEL // 2
N_SGU_GROUPS = 8
SGU_GROUP_DIM = SGU_WIDTH // N_SGU_GROUPS
SGU_CHUNK = 128
D_FF = 4 * D_MODEL
N_MOD = 6
IN_WIDTH = 3 * ATTN_WIDTH + 2 * SGU_WIDTH + 2 * D_MODEL
EPS = 1e-6

kernel_name = "hybrid_moba_gmlp_adaln_block"


def rmsnorm(x, g):
    xf = x.astype(jnp.float32)
    y = xf * lax.rsqrt(jnp.mean(xf * xf, axis=-1, keepdims=True) + EPS)
    return (y * g.astype(jnp.float32)).astype(x.dtype)


def moba_attention(q, k, v):
    B, S, H, Dh = q.shape
    L = MOBA_BLOCK
    nb = -(-S // L)
    s_pad = nb * L
    nqc = S // Q_CHUNK
    k_sel = min(MOBA_TOPK, nb - 1)
    scale = Dh ** -0.5
    qh = q.transpose(0, 2, 1, 3)
    pad = ((0, 0), (0, 0), (0, s_pad - S), (0, 0))
    kb = jnp.pad(k.transpose(0, 2, 1, 3), pad).reshape(B, H, nb, L, Dh)
    vb = jnp.pad(v.transpose(0, 2, 1, 3), pad).reshape(B, H, nb, L, Dh)
    qblk = jnp.arange(S) // L
    if k_sel > 0:
        kmean = jnp.mean(kb.astype(jnp.float32), axis=3)
        gate = jnp.einsum('bhsd,bhnd->bhsn', qh.astype(jnp.float32), kmean)
        fully_past = jnp.arange(nb)[None, :] < qblk[:, None]
        gate = jnp.where(fully_past[None, None], gate, -jnp.inf)
        _, idx = lax.top_k(gate, k_sel)
    else:
        idx = jnp.zeros((B, H, S, 0), jnp.int32)
    valid = idx < qblk[None, None, :, None]

    def to_chunks(a):
        tail = a.shape[3:]
        a = a.reshape((B, H, nqc, Q_CHUNK) + tail).swapaxes(1, 2)
        return a.reshape((B * nqc, H, Q_CHUNK) + tail)

    q_c = to_chunks(qh)
    idx_c = to_chunks(idx)
    valid_c = to_chunks(valid)
    b_ids = jnp.repeat(jnp.arange(B, dtype=jnp.int32), nqc)
    c_ids = jnp.tile(jnp.arange(nqc, dtype=jnp.int32), B)
    heads = jnp.arange(H)[:, None, None]
    offs_q = jnp.arange(Q_CHUNK)
    offs_k = jnp.arange(L)

    def attend_chunk(args):
        qi, ii, vi, bi, ci = args
        kb_b = lax.dynamic_index_in_dim(kb, bi, 0, keepdims=False)
        vb_b = lax.dynamic_index_in_dim(vb, bi, 0, keepdims=False)
        blk = (ci * Q_CHUNK) // L
        k_own = lax.dynamic_index_in_dim(kb_b, blk, 1, keepdims=False)
        v_own = lax.dynamic_index_in_dim(vb_b, blk, 1, keepdims=False)
        qf = qi.astype(jnp.float32) * scale
        s_own = jnp.einsum('hqd,hld->hql', qf, k_own.astype(jnp.float32))
        causal = (blk * L + offs_k)[None, :] <= (ci * Q_CHUNK + offs_q)[:, None]
        s_own = jnp.where(causal[None], s_own, -jnp.inf)
        k_g = kb_b[heads, ii]
        v_g = vb_b[heads, ii]
        s_g = jnp.einsum('hqd,hqkld->hqkl', qf, k_g.astype(jnp.float32))
        s_g = jnp.where(vi[..., None], s_g, -jnp.inf).reshape(H, Q_CHUNK, k_sel * L)
        p = jax.nn.softmax(jnp.concatenate([s_own, s_g], axis=-1), axis=-1)
        p_own = p[..., :L]
        p_g = p[..., L:].reshape(H, Q_CHUNK, k_sel, L)
        o = (jnp.einsum('hql,hld->hqd', p_own, v_own.astype(jnp.float32))
             + jnp.einsum('hqkl,hqkld->hqd', p_g, v_g.astype(jnp.float32)))
        return o.astype(qi.dtype)

    o = lax.map(attend_chunk, (q_c, idx_c, valid_c, b_ids, c_ids))
    o = o.reshape(B, nqc, H, Q_CHUNK, Dh).transpose(0, 1, 3, 2, 4)
    return o.reshape(B, S, H * Dh)


def spatial_gating(u, vs, g_v, w_s, b_s):
    B, S, _ = u.shape
    nc = S // SGU_CHUNK
    vs = rmsnorm(vs, g_v)
    vg = vs.reshape(B, nc, SGU_CHUNK, N_SGU_GROUPS, SGU_GROUP_DIM)
    w_causal = jnp.tril(w_s)
    z = jnp.einsum('gts,bcsgd->bctgd', w_causal, vg) + b_s.T[None, None, :, :, None]
    return u * z.reshape(B, S, SGU_WIDTH)


def setup_inputs(seed: int = 0) -> dict:
    key = jax.random.key(seed)
    ks = jax.random.split(key, 16)
    f32 = jnp.float32
    nrm = lambda k, shape, s: jax.random.normal(k, shape, f32) * s
    return {
        "x": nrm(ks[0], (BATCH, SEQ, D_MODEL), 1.0),
        "c": nrm(ks[1], (BATCH, D_MODEL), 1.0),
        "w_ada": nrm(ks[2], (DEPTH, D_MODEL, N_MOD * D_MODEL), 0.5 * D_MODEL ** -0.5),
        "b_ada": nrm(ks[3], (DEPTH, N_MOD * D_MODEL), 0.01),
        "g_mix": 1.0 + nrm(ks[4], (DEPTH, D_MODEL), 0.01),
        "w_in": nrm(ks[5], (DEPTH, D_MODEL, IN_WIDTH), D_MODEL ** -0.5),
        "w_proj_attn": nrm(ks[6], (DEPTH, ATTN_WIDTH, D_MODEL), ATTN_WIDTH ** -0.5),
        "g_sgu": 1.0 + nrm(ks[7], (DEPTH, SGU_WIDTH), 0.01),
        "w_sgu": nrm(ks[8], (DEPTH, N_SGU_GROUPS, SGU_CHUNK, SGU_CHUNK), SGU_CHUNK ** -0.5),
        "b_sgu": 1.0 + nrm(ks[9], (DEPTH, N_SGU_GROUPS, SGU_CHUNK), 0.01),
        "w_proj_sgu": nrm(ks[10], (DEPTH, SGU_WIDTH, D_MODEL), SGU_WIDTH ** -0.5),
        "w_out": nrm(ks[11], (DEPTH, D_MODEL, D_MODEL), D_MODEL ** -0.5),
        "g_ffn": 1.0 + nrm(ks[12], (DEPTH, D_MODEL), 0.01),
        "w_ff1": nrm(ks[13], (DEPTH, D_MODEL, D_FF), D_MODEL ** -0.5),
        "w_ff2": nrm(ks[14], (DEPTH, D_FF, D_MODEL), D_FF ** -0.5),
        "g_final": 1.0 + nrm(ks[15], (D_MODEL,), 0.01),
    }


def reference(x, c, w_ada, b_ada, g_mix, w_in, w_proj_attn, g_sgu, w_sgu, b_sgu,
              w_proj_sgu, w_out, g_ffn, w_ff1, w_ff2, g_final):
    B, S, _ = x.shape
    A, W, D = ATTN_WIDTH, SGU_WIDTH, D_MODEL
    splits = [A, 2 * A, 3 * A, 3 * A + W, 3 * A + 2 * W, 3 * A + 2 * W + D]
    c_act = jax.nn.silu(c)
    for l in range(DEPTH):
        mod = (c_act @ w_ada[l] + b_ada[l])[:, None, :]
        shift1, scale1, gate1, shift2, scale2, gate2 = jnp.split(mod, N_MOD, axis=-1)
        h = rmsnorm(x, g_mix[l]) * (1 + scale1) + shift1
        proj = h @ w_in[l]
        q, k, v, u, vs, ga, gb = jnp.split(proj, splits, axis=-1)
        hs = (B, S, N_ATTN_HEADS, HEAD_DIM)
        y_attn = moba_attention(q.reshape(hs), k.reshape(hs), v.reshape(hs)) @ w_proj_attn[l]
        y_sgu = spatial_gating(jax.nn.gelu(u), jax.nn.gelu(vs), g_sgu[l], w_sgu[l], b_sgu[l]) @ w_proj_sgu[l]
        merged = jax.nn.sigmoid(ga) * y_attn + jax.nn.sigmoid(gb) * y_sgu
        x = x + gate1 * (merged @ w_out[l])
        h = rmsnorm(x, g_ffn[l]) * (1 + scale2) + shift2
        x = x + gate2 * (jnp.square(jax.nn.relu(h @ w_ff1[l])) @ w_ff2[l])
    return rmsnorm(x, g_final)
```

```cpp
#include <hip/hip_runtime.h>
#include <hip/hip_cooperative_groups.h>
#include <cstdio>
#include <cstdint>
#include <cmath>
namespace pg8 {
#define PG8_LAS __attribute__((address_space(3)))
typedef unsigned short bf16_t;
typedef short bf16x8 __attribute__((ext_vector_type(8)));
typedef float f32x4 __attribute__((ext_vector_type(4)));
typedef unsigned u32x4 __attribute__((ext_vector_type(4)));
constexpr int BM = 256, BK = 64, HALF = 128, HTB = HALF * BK * 2  , STAGE_BYTES = 8 * HTB, NXCD = 8, WGM = 8;

__host__ __device__ __forceinline__ int lds_byte(int r, int c) { const int st = (r >> 4) * 2 + (c >> 5), rr = r & 15, cc = c & 31, ob = rr * 64 + cc * 2; return st * 1024 + (ob ^ (((ob >> 9) & 1) << 5)); }
__host__ __device__ __forceinline__ void stage_rc(int b, int& R, int& C) { const int st = b / 1024, sb = b % 1024, swz = sb ^ (((sb >> 9) & 1) << 5); R = (st >> 1) * 16 + swz / 64; C = (st & 1) * 32 + (swz % 64) / 2; }
__host__ __device__ __forceinline__ int perm32(int rho) { const int n = rho >> 4, i = rho & 15; return 8 * (i >> 2) + 4 * n + (i & 3); }

struct Unit { int pm, pn; };
struct Gemm { const bf16_t* A; const bf16_t* Bt; int M, N, K; };

struct StaticOrder {
    int nM, nN, nwg, G, c;
    __host__ __device__ void init(int M, int N, int G_, int c_) { nM = M / BM; nN = N / BM; nwg = nM * nN; G = G_; c = c_; }
    __host__ __device__ bool next(int i, Unit& u) const {
        const long L = (long)i * G + c; if (L >= nwg) return false;
        int wgid = (int)L; { const int q = nwg / NXCD, r = nwg % NXCD, xcd = wgid % NXCD, off = wgid / NXCD; wgid = (xcd < r ? xcd * (q + 1) : r * (q + 1) + (xcd - r) * q) + off; }
        const int nig = WGM * nN, gid = wgid / nig, fm = gid * WGM, gsz = (nM - fm) < WGM ? (nM - fm) : WGM;
        u.pm = fm + ((wgid % nig) % gsz); u.pn = (wgid % nig) / gsz; return true;
    }
    __device__ __forceinline__ void a_ready(const Unit&) const {}
    __device__ __forceinline__ void done(const Unit&) const {}
};
__device__ __forceinline__ unsigned cvt_pk_bf16(float lo, float hi) { unsigned r; asm volatile("v_cvt_pk_bf16_f32 %0, %1, %2" : "=v"(r) : "v"(lo), "v"(hi)); return r; }
typedef float f32x2 __attribute__((ext_vector_type(2)));
constexpr int MROWS = 65536;
constexpr float QSCALE = 0.125f * 1.4426950408889634f;
__device__ __forceinline__ float bf2f(unsigned short b) { return __builtin_bit_cast(float, (unsigned)b << 16); }
__device__ __forceinline__ float gelu_tanh_f(float x) {
    const float y = x * (1.0f + 0.044715f * x * x) * (-1.5957691216057308f * 1.4426950408889634f);
    return x * __builtin_amdgcn_rcpf(1.0f + __builtin_amdgcn_exp2f(y));
}
__device__ __forceinline__ float sigmoid_f(float x) { return __builtin_amdgcn_rcpf(1.0f + __builtin_amdgcn_exp2f(x * -1.4426950408889634f)); }

struct EpiIn {
    static constexpr bool PERM = true, AFTER_DRAIN = false;
    bf16_t* base0; float* ksum;
    __device__ __forceinline__ void operator()(const f32x4 (&acc)[2][2][4][2], const Unit& u, int wr, int wc, int fr, int fq) const {
        const int pn = u.pn; int kind, ldc, colt; size_t boff;
        if (pn < 10) { const int t = pn >> 1; boff = (size_t)t * MROWS * 512; ldc = 512; colt = (pn & 1) * 256; kind = (t == 0) ? 0 : (t < 3 ? 1 : 2); }
        else { const int t = (pn - 10) >> 2; boff = (size_t)5 * MROWS * 512 + (size_t)t * MROWS * 1024; ldc = 1024; colt = ((pn - 10) & 3) * 256; kind = 3; }
        bf16_t* base = base0 + boff;
        const int row0 = u.pm * BM + wr * 64 + fr, col0 = colt + wc * 32 + 8 * fq;
        if (pn == 2 || pn == 3) {
            float* kp = ksum + ((size_t)u.pm * 2 + wr) * 512 + col0;
#pragma unroll
            for (int bj = 0; bj < 2; ++bj)
#pragma unroll
                for (int n = 0; n < 2; ++n)
#pragma unroll
                    for (int i = 0; i < 4; ++i) {
                        float s = 0.f;
#pragma unroll
                        for (int ai = 0; ai < 2; ++ai)
#pragma unroll
                            for (int m = 0; m < 4; ++m) s += acc[ai][bj][m][n][i];
                        s += __shfl_xor(s, 1); s += __shfl_xor(s, 2); s += __shfl_xor(s, 4); s += __shfl_xor(s, 8);
                        if (fr == 0) kp[bj * HALF + 4 * n + i] = s;
                    }
        }
#pragma unroll
        for (int ai = 0; ai < 2; ++ai)
#pragma unroll
            for (int m = 0; m < 4; ++m) { bf16_t* rowp = base + (size_t)(row0 + ai * HALF + m * 16) * ldc + col0;
#pragma unroll
                for (int bj = 0; bj < 2; ++bj) { f32x4 v0 = acc[ai][bj][m][0], v1 = acc[ai][bj][m][1];
                    if (kind == 0) { v0 = v0 * QSCALE; v1 = v1 * QSCALE; }
                    else if (kind == 2) {
#pragma unroll
                        for (int i = 0; i < 4; ++i) { v0[i] = gelu_tanh_f(v0[i]); v1[i] = gelu_tanh_f(v1[i]); } }
                    else if (kind == 3) {
#pragma unroll
                        for (int i = 0; i < 4; ++i) { v0[i] = sigmoid_f(v0[i]); v1[i] = sigmoid_f(v1[i]); } }
                    u32x4 w; w.x = cvt_pk_bf16(v0[0], v0[1]); w.y = cvt_pk_bf16(v0[2], v0[3]); w.z = cvt_pk_bf16(v1[0], v1[1]); w.w = cvt_pk_bf16(v1[2], v1[3]);
                    *(u32x4*)(rowp + bj * HALF) = w; } }
    }
};
template <int MODE> struct EpiMul {
    static constexpr bool PERM = true, AFTER_DRAIN = false;
    bf16_t* G; const bf16_t* Hh;
    __device__ __forceinline__ void operator()(const f32x4 (&acc)[2][2][4][2], const Unit& u, int wr, int wc, int fr, int fq) const {
        const int row0 = u.pm * BM + wr * 64 + fr, col0 = u.pn * BM + wc * 32 + 8 * fq;
#pragma unroll
        for (int ai = 0; ai < 2; ++ai)
#pragma unroll
            for (int m = 0; m < 4; ++m) { const size_t off = (size_t)(row0 + ai * HALF + m * 16) * 1024 + col0;
#pragma unroll
                for (int bj = 0; bj < 2; ++bj) { const f32x4 a0 = acc[ai][bj][m][0], a1 = acc[ai][bj][m][1];
                    const u32x4 g = *(const u32x4*)(G + off + bj * HALF); float r[8];
                    const float gf[8] = {bf2f(g.x & 0xffff), bf2f(g.x >> 16), bf2f(g.y & 0xffff), bf2f(g.y >> 16), bf2f(g.z & 0xffff), bf2f(g.z >> 16), bf2f(g.w & 0xffff), bf2f(g.w >> 16)};
                    if (MODE == 0) {
#pragma unroll
                        for (int i = 0; i < 4; ++i) { r[i] = gf[i] * a0[i]; r[4 + i] = gf[4 + i] * a1[i]; }
                    } else {
                        const u32x4 h = *(const u32x4*)(Hh + off + bj * HALF);
                        const float hf[8] = {bf2f(h.x & 0xffff), bf2f(h.x >> 16), bf2f(h.y & 0xffff), bf2f(h.y >> 16), bf2f(h.z & 0xffff), bf2f(h.z >> 16), bf2f(h.w & 0xffff), bf2f(h.w >> 16)};
#pragma unroll
                        for (int i = 0; i < 4; ++i) { r[i] = gf[i] + hf[i] * a0[i]; r[4 + i] = gf[4 + i] + hf[4 + i] * a1[i]; }
                    }
                    u32x4 w; w.x = cvt_pk_bf16(r[0], r[1]); w.y = cvt_pk_bf16(r[2], r[3]); w.z = cvt_pk_bf16(r[4], r[5]); w.w = cvt_pk_bf16(r[6], r[7]);
                    *(u32x4*)(G + off + bj * HALF) = w; } }
    }
};
struct EpiRes {
    static constexpr bool PERM = false, AFTER_DRAIN = false;
    const float* base; float* out; const float* gate;
    __device__ __forceinline__ void operator()(const f32x4 (&acc)[2][2][4][2], const Unit& u, int wr, int wc, int fr, int fq) const {
        const int row0 = u.pm * BM + wr * 64 + fr, col0 = u.pn * BM + wc * 32 + 4 * fq;
        const float* gp = gate + (size_t)(u.pm >> 3) * 6144 + col0;
#pragma unroll
        for (int bj = 0; bj < 2; ++bj)
#pragma unroll
            for (int n = 0; n < 2; ++n) { const f32x4 gv = *(const f32x4*)(gp + bj * HALF + n * 16);
#pragma unroll
                for (int ai = 0; ai < 2; ++ai)
#pragma unroll
                    for (int m = 0; m < 4; ++m) { const size_t off = (size_t)(row0 + ai * HALF + m * 16) * 1024 + col0 + bj * HALF + n * 16;
                        const f32x4 bs = *(const f32x4*)(base + off); *(f32x4*)(out + off) = bs + gv * acc[ai][bj][m][n]; } }
    }
};
struct EpiRelu2 {
    static constexpr bool PERM = true, AFTER_DRAIN = false;
    bf16_t* O;
    __device__ __forceinline__ void operator()(const f32x4 (&acc)[2][2][4][2], const Unit& u, int wr, int wc, int fr, int fq) const {
        const int row0 = u.pm * BM + wr * 64 + fr, col0 = u.pn * BM + wc * 32 + 8 * fq;
#pragma unroll
        for (int ai = 0; ai < 2; ++ai)
#pragma unroll
            for (int m = 0; m < 4; ++m) { bf16_t* rowp = O + (size_t)(row0 + ai * HALF + m * 16) * 4096 + col0;
#pragma unroll
                for (int bj = 0; bj < 2; ++bj) { f32x4 v0 = acc[ai][bj][m][0], v1 = acc[ai][bj][m][1];
#pragma unroll
                    for (int i = 0; i < 4; ++i) { const float a = fmaxf(v0[i], 0.f), b = fmaxf(v1[i], 0.f); v0[i] = a * a; v1[i] = b * b; }
                    u32x4 w; w.x = cvt_pk_bf16(v0[0], v0[1]); w.y = cvt_pk_bf16(v0[2], v0[3]); w.z = cvt_pk_bf16(v1[0], v1[1]); w.w = cvt_pk_bf16(v1[2], v1[3]);
                    *(u32x4*)(rowp + bj * HALF) = w; } }
    }
};
template <class Epi, class Sched, bool ALIGN_EPI = false, bool SP2 = false>
__device__ __forceinline__ void gemm_phase(PG8_LAS unsigned char* lds, const Gemm g, const Sched& S, const Epi& E) {
    const int tid = threadIdx.x, wid = __builtin_amdgcn_readfirstlane(tid >> 6), lane = tid & 63, wr = wid >> 2, wc = wid & 3, fr = lane & 15, fq = lane >> 4;
    const int K = g.K, nt = K / BK;
    unsigned voffA[2], voffB[2];
#pragma unroll
    for (int i = 0; i < 2; ++i) { int R, C; stage_rc(tid * 16 + i * 8192, R, C); const int Rb = Epi::PERM ? ((R & ~31) + perm32(R & 31)) : R;
        voffA[i] = (unsigned)(R * K + C) * 2u; voffB[i] = (unsigned)(Rb * K + C) * 2u; }
    const size_t kstep = (size_t)(BK * 2);
    const size_t hstep = (size_t)HALF * K * 2;
    const size_t tstep = 2 * hstep;
    const unsigned ldsw = (unsigned)wid * 1024u;
    const int aoff = lds_byte(wr * 64 + fr, fq * 8), boff = lds_byte(wc * 32 + fr, fq * 8);
#define PG8_SA(b, h) (((b) * 2 + (h)) * HTB)
#define PG8_SB(b, h) ((4 + (b) * 2 + (h)) * HTB)
#define PG8_STAGE(bufoff, gbase, voff) do { _Pragma("unroll") for (int _i = 0; _i < 2; ++_i) \
        __builtin_amdgcn_global_load_lds((const unsigned*)((const char*)(gbase) + (voff)[_i]), (PG8_LAS unsigned*)(lds + (bufoff) + ldsw + _i * 8192), 16, 0, 0); } while (0)
#define PG8_LDA(dst, b, h) do { _Pragma("unroll") for (int m = 0; m < 4; ++m) _Pragma("unroll") for (int k = 0; k < 2; ++k) dst[m][k] = *(const PG8_LAS bf16x8*)(lds + PG8_SA(b, h) + aoff + m * 2048 + k * 1024); } while (0)
#define PG8_LDB(dst, b, h) do { _Pragma("unroll") for (int n = 0; n < 2; ++n) _Pragma("unroll") for (int k = 0; k < 2; ++k) dst[n][k] = *(const PG8_LAS bf16x8*)(lds + PG8_SB(b, h) + boff + n * 2048 + k * 1024); } while (0)
#define PG8_MMA(ai, bj, At, Bt) do { __builtin_amdgcn_s_setprio(1); _Pragma("unroll") for (int m = 0; m < 4; ++m) _Pragma("unroll") for (int n = 0; n < 2; ++n) _Pragma("unroll") for (int k = 0; k < 2; ++k) \
        acc[ai][bj][m][n] = __builtin_amdgcn_mfma_f32_16x16x32_bf16(Bt[n][k], At[m][k], acc[ai][bj][m][n], 0, 0, 0); __builtin_amdgcn_s_setprio(0); } while (0)
#define PG8_WAIT_V(n) asm volatile("s_waitcnt vmcnt(" #n ")" ::: "memory")
#define PG8_WAIT_L(n) asm volatile("s_waitcnt lgkmcnt(" #n ")" ::: "memory")
#define PG8_BAR __builtin_amdgcn_s_barrier()
#define PG8_SCHED __builtin_amdgcn_sched_barrier(0)
    Unit cur, nxt; int ui = 0;
    if (!S.next(0, cur)) return;
    f32x4 acc[2][2][4][2];
#pragma unroll
    for (int a = 0; a < 2; ++a)
#pragma unroll
        for (int b = 0; b < 2; ++b)
#pragma unroll
            for (int m = 0; m < 4; ++m)
#pragma unroll
                for (int n = 0; n < 2; ++n) acc[a][b][m][n] = (f32x4){0.f, 0.f, 0.f, 0.f};
    bf16x8 At[4][2], B0[2][2], B1[2][2];
    const char* cA = (const char*)g.A + (size_t)cur.pm * tstep; const char* cB = (const char*)g.Bt + (size_t)cur.pn * tstep;
    S.a_ready(cur);
    if constexpr (SP2) {
        PG8_STAGE(PG8_SB(0, 0), cB, voffB); PG8_STAGE(PG8_SB(0, 1), cB + hstep, voffB); PG8_STAGE(PG8_SA(0, 0), cA, voffA); PG8_STAGE(PG8_SA(0, 1), cA + hstep, voffA);
        if (wr == 1) PG8_BAR;
        PG8_WAIT_V(2); PG8_BAR;
        PG8_STAGE(PG8_SB(1, 0), cB + kstep, voffB); PG8_STAGE(PG8_SA(1, 0), cA + kstep, voffA); PG8_STAGE(PG8_SB(1, 1), cB + hstep + kstep, voffB);
        PG8_WAIT_V(6); PG8_BAR;
    } else {
        PG8_STAGE(PG8_SB(0, 0), cB, voffB); PG8_STAGE(PG8_SA(0, 0), cA, voffA); PG8_STAGE(PG8_SB(0, 1), cB + hstep, voffB); PG8_STAGE(PG8_SA(0, 1), cA + hstep, voffA);
        if (wr == 1) PG8_BAR;
        PG8_WAIT_V(4); PG8_BAR;
        PG8_STAGE(PG8_SB(1, 0), cB + kstep, voffB); PG8_STAGE(PG8_SA(1, 0), cA + kstep, voffA); PG8_STAGE(PG8_SB(1, 1), cB + hstep + kstep, voffB);
        PG8_WAIT_V(6); PG8_BAR;
    }
    for (;;) {
        const bool has_next = S.next(ui + 1, nxt);
        const char* nA = has_next ? (const char*)g.A + (size_t)nxt.pm * tstep : cA; const char* nB = has_next ? (const char*)g.Bt + (size_t)nxt.pn * tstep : cB;
        for (int t = 0; t < nt; t += 2) {
            const bool last = (t == nt - 2);
            const char* a1 = cA + (size_t)(t + 1) * kstep;
            const char* a2 = last ? nA : cA + (size_t)(t + 2) * kstep; const char* b2 = last ? nB : cB + (size_t)(t + 2) * kstep;
            const char* a3 = a2 + kstep; const char* b3 = b2 + kstep;
            if (last && has_next) S.a_ready(nxt);
            if constexpr (SP2) {
            PG8_LDB(B0, 0, 0); PG8_LDB(B1, 0, 1); PG8_SCHED; PG8_LDA(At, 0, 0); PG8_STAGE(PG8_SA(1, 1), a1 + hstep, voffA);
            PG8_WAIT_V(8); PG8_WAIT_L(0); PG8_BAR; PG8_MMA(0, 0, At, B0); PG8_MMA(0, 1, At, B1); PG8_BAR; PG8_SCHED;
            PG8_LDA(At, 0, 1); PG8_STAGE(PG8_SB(0, 0), b2, voffB); PG8_STAGE(PG8_SB(0, 1), b2 + hstep, voffB); PG8_STAGE(PG8_SA(0, 0), a2, voffA);
            PG8_WAIT_V(8); PG8_WAIT_L(0); PG8_BAR; PG8_MMA(1, 0, At, B0); PG8_MMA(1, 1, At, B1); PG8_BAR; PG8_SCHED;
            PG8_LDB(B0, 1, 0); PG8_LDB(B1, 1, 1); PG8_SCHED; PG8_LDA(At, 1, 0); PG8_STAGE(PG8_SA(0, 1), a2 + hstep, voffA);
            PG8_WAIT_V(8); PG8_WAIT_L(0); PG8_BAR; PG8_MMA(0, 0, At, B0); PG8_MMA(0, 1, At, B1); PG8_BAR; PG8_SCHED;
            PG8_LDA(At, 1, 1); PG8_STAGE(PG8_SB(1, 0), b3, voffB); PG8_STAGE(PG8_SB(1, 1), b3 + hstep, voffB); PG8_STAGE(PG8_SA(1, 0), a3, voffA);
            PG8_WAIT_V(8); PG8_WAIT_L(0); PG8_BAR; PG8_MMA(1, 0, At, B0); PG8_MMA(1, 1, At, B1); PG8_BAR; PG8_SCHED;
            } else {
            PG8_LDB(B0, 0, 0); PG8_SCHED; PG8_LDA(At, 0, 0); PG8_STAGE(PG8_SA(1, 1), a1 + hstep, voffA);
            PG8_WAIT_L(8); PG8_BAR; PG8_WAIT_L(0); PG8_MMA(0, 0, At, B0); PG8_BAR; PG8_SCHED;
            PG8_LDB(B1, 0, 1); PG8_STAGE(PG8_SB(0, 0), b2, voffB);
            PG8_BAR; PG8_WAIT_L(0); PG8_MMA(0, 1, At, B1); PG8_BAR;
            PG8_LDA(At, 0, 1); PG8_STAGE(PG8_SA(0, 0), a2, voffA);
            PG8_BAR; PG8_WAIT_L(0); PG8_MMA(1, 0, At, B0); PG8_BAR; PG8_SCHED;
            PG8_STAGE(PG8_SB(0, 1), b2 + hstep, voffB);
            PG8_WAIT_V(6); PG8_BAR; PG8_MMA(1, 1, At, B1); PG8_BAR;
            PG8_LDB(B0, 1, 0); PG8_SCHED; PG8_LDA(At, 1, 0); PG8_STAGE(PG8_SA(0, 1), a2 + hstep, voffA);
            PG8_WAIT_L(8); PG8_BAR; PG8_WAIT_L(0); PG8_MMA(0, 0, At, B0); PG8_BAR; PG8_SCHED;
            PG8_LDB(B1, 1, 1); PG8_STAGE(PG8_SB(1, 0), b3, voffB);
            PG8_BAR; PG8_WAIT_L(0); PG8_MMA(0, 1, At, B1); PG8_BAR;
            PG8_LDA(At, 1, 1); PG8_STAGE(PG8_SA(1, 0), a3, voffA);
            PG8_BAR; PG8_WAIT_L(0); PG8_MMA(1, 0, At, B0); PG8_BAR; PG8_SCHED;
            PG8_STAGE(PG8_SB(1, 1), b3 + hstep, voffB);
            PG8_WAIT_V(6); PG8_BAR; PG8_MMA(1, 1, At, B1); PG8_BAR;
            }
        }
        if constexpr (ALIGN_EPI) { if (wr == 0) PG8_BAR; }
        if constexpr (!Epi::AFTER_DRAIN) { E(acc, cur, wr, wc, fr, fq); S.done(cur); }
        if (!has_next) break;
#pragma unroll
        for (int a = 0; a < 2; ++a)
#pragma unroll
            for (int b = 0; b < 2; ++b)
#pragma unroll
                for (int m = 0; m < 4; ++m)
#pragma unroll
                    for (int n = 0; n < 2; ++n) acc[a][b][m][n] = (f32x4){0.f, 0.f, 0.f, 0.f};
        cur = nxt; cA = nA; cB = nB; ++ui;
        if constexpr (ALIGN_EPI) { if (wr == 1) PG8_BAR; }
    }
    PG8_WAIT_V(0);
    if constexpr (!ALIGN_EPI) { if (wr == 0) PG8_BAR; }
    PG8_BAR;
    if constexpr (Epi::AFTER_DRAIN) { E.fused(acc, cur, wr, wc, fr, fq, lds, wid, lane); S.done(cur); }
#undef PG8_SA
#undef PG8_SB
#undef PG8_STAGE
#undef PG8_LDA
#undef PG8_LDB
#undef PG8_MMA
#undef PG8_WAIT_V
#undef PG8_WAIT_L
#undef PG8_BAR
#undef PG8_SCHED
}
}

namespace cg = cooperative_groups;
#define LAS __attribute__((address_space(3)))
typedef unsigned short bf16;
typedef unsigned v4u __attribute__((ext_vector_type(4)));
typedef unsigned v2u __attribute__((ext_vector_type(2)));
typedef float f32x4 __attribute__((ext_vector_type(4)));
typedef float f32x16 __attribute__((ext_vector_type(16)));
typedef short bf16x8 __attribute__((ext_vector_type(8)));
typedef short s16x4 __attribute__((ext_vector_type(4)));

constexpr int BATCH = 32, SEQ = 2048, DM = 1024, M = BATCH * SEQ, AW = 512, SW = 512, INW = 4608, DFF = 4096, NMODW = 6 * DM;
constexpr float EPS = 1e-6f;
constexpr int NWAVES = 8, LDS_BYTES = 147456;
constexpr size_t MiB = 1u << 20;
constexpr size_t WS_MOD = 1 * MiB, WS_KSUM = 2 * MiB, WS_WSGU = 3 * MiB, WS_WIN = 4 * MiB, WS_WPA = 13 * MiB, WS_WPS = 14 * MiB, WS_WOUT = 15 * MiB, WS_WFF1 = 17 * MiB, WS_WFF2 = 25 * MiB;
constexpr size_t WS_H = 64 * MiB, WS_Q = 192 * MiB, WS_K = 256 * MiB, WS_V = 320 * MiB, WS_U = 384 * MiB, WS_VS = 448 * MiB, WS_GA = 512 * MiB, WS_GB = 640 * MiB, WS_ATTO = 768 * MiB, WS_SGUO = 832 * MiB, WS_END = 896 * MiB;
constexpr size_t WS_HID = 192 * MiB;

__device__ __forceinline__ unsigned f2bf(float f) { unsigned u = __builtin_bit_cast(unsigned, f); return (u + 0x7fffu + ((u >> 16) & 1u)) >> 16; }
__device__ __forceinline__ unsigned pk2(float lo, float hi) { return f2bf(lo) | (f2bf(hi) << 16); }
__device__ __forceinline__ float bf2f(unsigned short b) { return __builtin_bit_cast(float, (unsigned)b << 16); }
__device__ __forceinline__ float wave_sum(float v) {
#pragma unroll
    for (int o = 1; o < 64; o <<= 1) v += __shfl_xor(v, o);
    return v;
}
#define LDS_WAIT() asm volatile("s_waitcnt lgkmcnt(0)" ::: "memory")

__device__ __forceinline__ void transpose_item(const float* W, int K, int N, bf16* WT, LAS float* scr, int item, int lane) {
    const int nblk = N / 32, kb = item / nblk, nb = item % nblk, k0 = 64 * kb, n0 = 32 * nb;
#pragma unroll 8
    for (int i = 0; i < 32; ++i) { const int kk = 2 * i + (lane >> 5); scr[kk * 33 + (lane & 31)] = W[(size_t)(k0 + kk) * N + n0 + (lane & 31)]; }
    LDS_WAIT(); asm volatile("" ::: "memory");
    const int c = lane & 7;
#pragma unroll
    for (int j = 0; j < 4; ++j) { const int n = (lane >> 3) + 8 * j; const LAS float* s = scr + (8 * c) * 33 + n;
        v4u o; o.x = pk2(s[0 * 33], s[1 * 33]); o.y = pk2(s[2 * 33], s[3 * 33]); o.z = pk2(s[4 * 33], s[5 * 33]); o.w = pk2(s[6 * 33], s[7 * 33]);
        *(v4u*)(WT + (size_t)(n0 + n) * K + k0 + 8 * c) = o; }
    LDS_WAIT(); asm volatile("" ::: "memory");
}

__device__ __forceinline__ void norm_rows_bf16(const float* src, bf16* dst, const float* g, const float* mod, int shift_off, int scale_off, int gw, int NGW, int lane) {
    for (int m = gw; m < M; m += NGW) {
        const int b = m >> 11;
        const f32x4* xr = (const f32x4*)(src + (size_t)m * DM) + lane;
        f32x4 v[4]; float ss = 0.f;
#pragma unroll
        for (int j = 0; j < 4; ++j) { v[j] = xr[64 * j]; ss += (v[j].x * v[j].x + v[j].y * v[j].y) + (v[j].z * v[j].z + v[j].w * v[j].w); }
        const float rstd = 1.0f / sqrtf(wave_sum(ss) * (1.0f / DM) + EPS);
        const float* mb = mod + (size_t)b * NMODW;
        v2u* o8 = (v2u*)(dst + (size_t)m * DM) + lane;
#pragma unroll
        for (int j = 0; j < 4; ++j) { const int col = 4 * lane + 256 * j;
            const f32x4 gg = *(const f32x4*)(g + col), sc = *(const f32x4*)(mb + scale_off + col), sh = *(const f32x4*)(mb + shift_off + col);
            const f32x4 h = v[j] * rstd * gg * (sc + 1.0f) + sh;
            v2u w; w.x = pk2(h.x, h.y); w.y = pk2(h.z, h.w); o8[64 * j] = w; }
    }
}
__device__ __forceinline__ void norm_rows_final(float* x, const float* g, int gw, int NGW, int lane) {
    for (int m = gw; m < M; m += NGW) {
        f32x4* xr = (f32x4*)(x + (size_t)m * DM) + lane;
        f32x4 v[4]; float ss = 0.f;
#pragma unroll
        for (int j = 0; j < 4; ++j) { v[j] = xr[64 * j]; ss += (v[j].x * v[j].x + v[j].y * v[j].y) + (v[j].z * v[j].z + v[j].w * v[j].w); }
        const float rstd = 1.0f / sqrtf(wave_sum(ss) * (1.0f / DM) + EPS);
#pragma unroll
        for (int j = 0; j < 4; ++j) { const f32x4 gg = *(const f32x4*)(g + 4 * lane + 256 * j); xr[64 * j] = v[j] * rstd * gg; }
    }
}

__device__ __forceinline__ void mod_item(const float* c, const float* w_ada, const float* b_ada, float* mod, int item, LAS unsigned char* lds, int tid) {
    LAS float* cat = (LAS float*)lds;
    for (int idx = tid; idx < BATCH * DM; idx += 512) { const int b = idx >> 10, k = idx & 1023; const float v = c[idx]; cat[b * 1028 + k] = v / (1.0f + expf(-v)); }
    __syncthreads();
    const int col = tid & 31, kp = tid >> 5, n0 = item * 32;
    float acc[32];
#pragma unroll
    for (int b = 0; b < 32; ++b) acc[b] = 0.f;
    for (int kk = 0; kk < 64; kk += 4) {
        const int k = kp * 64 + kk;
        const float* wp = w_ada + (size_t)k * NMODW + n0 + col;
        const float w0 = wp[0], w1 = wp[NMODW], w2 = wp[2 * NMODW], w3 = wp[3 * NMODW];
#pragma unroll
        for (int b = 0; b < 32; ++b) { const f32x4 cv = *(const LAS f32x4*)(cat + b * 1028 + k); acc[b] += (cv.x * w0 + cv.y * w1) + (cv.z * w2 + cv.w * w3); }
    }
    __syncthreads();
    LAS float* red = (LAS float*)lds;
#pragma unroll
    for (int b = 0; b < 32; ++b) red[(kp * 32 + b) * 32 + col] = acc[b];
    __syncthreads();
#pragma unroll
    for (int j = 0; j < 2; ++j) { const int o = tid + 512 * j, b = o >> 5, cc = o & 31; float s = 0.f;
#pragma unroll
        for (int q = 0; q < 16; ++q) s += red[(q * 32 + b) * 32 + cc];
        mod[(size_t)b * NMODW + n0 + cc] = s + b_ada[n0 + cc]; }
    __syncthreads();
}

__device__ __forceinline__ int crow(int r, int hi) { return (r & 3) + 8 * (r >> 2) + 4 * hi; }

constexpr int AT_KROW = 72;
constexpr int AT_KT = 0, AT_VT = 2 * 64 * AT_KROW * 2, AT_KMS = 2 * AT_VT;
__device__ __forceinline__ void attn_unit(int b, int h, int qb, const bf16* Q, const bf16* K, const bf16* V, bf16* O, const float* KSUM, LAS unsigned char* lds, int tid) {
    const int lane = tid & 63, w = __builtin_amdgcn_readfirstlane(tid >> 6), r32 = lane & 31, hi = lane >> 5;
    LAS float* kms = (LAS float*)(lds + AT_KMS);
    const size_t rowbase = (size_t)b * SEQ;
    { const int n = tid >> 6, d = tid & 63; const float* p = KSUM + ((size_t)(b * 8 + n) * 2) * 512 + h * 64 + d; kms[n * 64 + d] = p[0] + p[512]; }
    const int qrel = w * 32 + r32;
    const bf16* qp = Q + (rowbase + qb * 256 + qrel) * AW + h * 64;
    bf16x8 qr[4];
#pragma unroll
    for (int ds = 0; ds < 4; ++ds) qr[ds] = *(const bf16x8*)(qp + ds * 16 + hi * 8);
    __syncthreads();
    unsigned sel = 0u;
    if (qb <= 3) sel = (1u << qb) - 1u;
    else {
        float gt[8];
#pragma unroll
        for (int n = 0; n < 8; ++n) { float s = 0.f;
#pragma unroll
            for (int ds = 0; ds < 4; ++ds) { const f32x4 k0 = *(const LAS f32x4*)(kms + n * 64 + ds * 16 + hi * 8), k1 = *(const LAS f32x4*)(kms + n * 64 + ds * 16 + hi * 8 + 4);
                s += bf2f((unsigned short)qr[ds][0]) * k0.x + bf2f((unsigned short)qr[ds][1]) * k0.y + bf2f((unsigned short)qr[ds][2]) * k0.z + bf2f((unsigned short)qr[ds][3]) * k0.w
                   + bf2f((unsigned short)qr[ds][4]) * k1.x + bf2f((unsigned short)qr[ds][5]) * k1.y + bf2f((unsigned short)qr[ds][6]) * k1.z + bf2f((unsigned short)qr[ds][7]) * k1.w; }
            gt[n] = s + __shfl_xor(s, 32); }
#pragma unroll
        for (int rnd = 0; rnd < 3; ++rnd) { float best = -INFINITY; int bi = 0;
#pragma unroll
            for (int n = 0; n < 8; ++n) { const bool ok = (n < qb) && !((sel >> n) & 1u) && (gt[n] > best); best = ok ? gt[n] : best; bi = ok ? n : bi; }
            sel |= 1u << bi; }
    }
    const int ntiles = 4 * (qb + 1);
    const bf16* kg = K + (rowbase + (tid >> 3)) * AW + h * 64 + (tid & 7) * 8;
    const bf16* vg = V + (rowbase + lane) * AW + h * 64 + w * 8;
    v4u kreg = *(const v4u*)(kg + (size_t)(qb * 256) * AW), vreg = *(const v4u*)(vg + (size_t)(qb * 256) * AW);
    float mrun = -INFINITY, lrun = 0.f; f32x16 o0 = {}, o1 = {};
    for (int it = 0; it < ntiles; ++it) {
        const int buf = it & 1;
        LAS unsigned char* kt = lds + AT_KT + buf * (64 * AT_KROW * 2); LAS unsigned char* vt = lds + AT_VT + buf * (64 * AT_KROW * 2);
        *(LAS v4u*)(kt + (tid >> 3) * (AT_KROW * 2) + (tid & 7) * 16) = kreg;
        { LAS unsigned short* vp = (LAS unsigned short*)vt + (w * 8) * AT_KROW + lane;
          vp[0 * AT_KROW] = (unsigned short)(vreg.x & 0xffff); vp[1 * AT_KROW] = (unsigned short)(vreg.x >> 16); vp[2 * AT_KROW] = (unsigned short)(vreg.y & 0xffff); vp[3 * AT_KROW] = (unsigned short)(vreg.y >> 16);
          vp[4 * AT_KROW] = (unsigned short)(vreg.z & 0xffff); vp[5 * AT_KROW] = (unsigned short)(vreg.z >> 16); vp[6 * AT_KROW] = (unsigned short)(vreg.w & 0xffff); vp[7 * AT_KROW] = (unsigned short)(vreg.w >> 16); }
        __syncthreads();
        if (it + 1 < ntiles) { const int nx = it + 1; const int kb = (nx < 4) ? qb * 256 + nx * 64 : (nx - 4) * 64;
            kreg = *(const v4u*)(kg + (size_t)kb * AW); vreg = *(const v4u*)(vg + (size_t)kb * AW); }
        const bool own = it < 4; const int t = it & 3, blk = (it - 4) >> 2;
        const bool mysel = own || ((sel >> blk) & 1u);
        const bool active = own ? (64 * t <= 32 * w + 31) : (__any(mysel ? 1 : 0) != 0);
        if (active) {
            const float pen = mysel ? 0.f : -INFINITY;
            f32x16 s0, s1;
#pragma unroll
            for (int r = 0; r < 16; ++r) { s0[r] = pen; s1[r] = pen; }
#pragma unroll
            for (int ds = 0; ds < 4; ++ds) {
                const bf16x8 a0 = *(const LAS bf16x8*)(kt + r32 * (AT_KROW * 2) + ds * 32 + hi * 16);
                const bf16x8 a1 = *(const LAS bf16x8*)(kt + (32 + r32) * (AT_KROW * 2) + ds * 32 + hi * 16);
                s0 = __builtin_amdgcn_mfma_f32_32x32x16_bf16(a0, qr[ds], s0, 0, 0, 0);
                s1 = __builtin_amdgcn_mfma_f32_32x32x16_bf16(a1, qr[ds], s1, 0, 0, 0);
            }
            if (own) {
#pragma unroll
                for (int r = 0; r < 16; ++r) { const int kv = 64 * t + crow(r, hi); if (kv > qrel) s0[r] = -INFINITY; if (kv + 32 > qrel) s1[r] = -INFINITY; }
            }
            float mx = fmaxf(s0[0], s1[0]);
#pragma unroll
            for (int r = 1; r < 16; ++r) mx = fmaxf(mx, fmaxf(s0[r], s1[r]));
            mx = fmaxf(mx, __shfl_xor(mx, 32));
            const float mnew = fmaxf(mrun, mx);
            const float f = __builtin_amdgcn_exp2f(mrun - mnew);
            mrun = mnew;
            float ps = 0.f;
#pragma unroll
            for (int r = 0; r < 16; ++r) { s0[r] = __builtin_amdgcn_exp2f(s0[r] - mnew); s1[r] = __builtin_amdgcn_exp2f(s1[r] - mnew); ps += s0[r] + s1[r]; }
            lrun = lrun * f + ps;
#pragma unroll
            for (int r = 0; r < 16; ++r) { o0[r] *= f; o1[r] *= f; }
            v4u pw[4];
            pw[0] = (v4u){pk2(s0[0], s0[1]), pk2(s0[2], s0[3]), pk2(s0[4], s0[5]), pk2(s0[6], s0[7])};
            pw[1] = (v4u){pk2(s0[8], s0[9]), pk2(s0[10], s0[11]), pk2(s0[12], s0[13]), pk2(s0[14], s0[15])};
            pw[2] = (v4u){pk2(s1[0], s1[1]), pk2(s1[2], s1[3]), pk2(s1[4], s1[5]), pk2(s1[6], s1[7])};
            pw[3] = (v4u){pk2(s1[8], s1[9]), pk2(s1[10], s1[11]), pk2(s1[12], s1[13]), pk2(s1[14], s1[15])};
#pragma unroll
            for (int j = 0; j < 4; ++j) {
                const bf16x8 pb = __builtin_bit_cast(bf16x8, pw[j]);
                { const LAS unsigned char* vp = vt + r32 * (AT_KROW * 2) + (16 * j + 4 * hi) * 2;
                  const s16x4 lo = *(const LAS s16x4*)vp, hh = *(const LAS s16x4*)(vp + 16);
                  const bf16x8 va = {lo[0], lo[1], lo[2], lo[3], hh[0], hh[1], hh[2], hh[3]};
                  o0 = __builtin_amdgcn_mfma_f32_32x32x16_bf16(va, pb, o0, 0, 0, 0); }
                { const LAS unsigned char* vp = vt + (32 + r32) * (AT_KROW * 2) + (16 * j + 4 * hi) * 2;
                  const s16x4 lo = *(const LAS s16x4*)vp, hh = *(const LAS s16x4*)(vp + 16);
                  const bf16x8 va = {lo[0], lo[1], lo[2], lo[3], hh[0], hh[1], hh[2], hh[3]};
                  o1 = __builtin_amdgcn_mfma_f32_32x32x16_bf16(va, pb, o1, 0, 0, 0); }
            }
        }
    }
    const float inv = 1.0f / (lrun + __shfl_xor(lrun, 32));
    bf16* op = O + (rowbase + qb * 256 + qrel) * AW + h * 64 + 4 * hi;
#pragma unroll
    for (int g = 0; g < 4; ++g) {
        v2u a; a.x = pk2(o0[4 * g] * inv, o0[4 * g + 1] * inv); a.y = pk2(o0[4 * g + 2] * inv, o0[4 * g + 3] * inv); *(v2u*)(op + 8 * g) = a;
        v2u c; c.x = pk2(o1[4 * g] * inv, o1[4 * g + 1] * inv); c.y = pk2(o1[4 * g + 2] * inv, o1[4 * g + 3] * inv); *(v2u*)(op + 32 + 8 * g) = c;
    }
    __syncthreads();
}

constexpr int SG_ROW = 136;
constexpr int SG_WAVE_BYTES = 64 * SG_ROW * 2, SG_RS = 8 * SG_WAVE_BYTES;
__device__ __forceinline__ void sgu_unit(int b, int ch, const bf16* U, const bf16* VS, bf16* O, const bf16* WS, const float* g_sgu, const float* b_sgu, LAS unsigned char* lds, int tid) {
    const int lane = tid & 63, g = __builtin_amdgcn_readfirstlane(tid >> 6), r32 = lane & 31, hi = lane >> 5;
    const size_t r0 = (size_t)b * SEQ + ch * 128;
    LAS float* rs = (LAS float*)(lds + SG_RS);
#pragma unroll 4
    for (int i = 0; i < 16; ++i) { const int t = 16 * g + i; const v4u v = *(const v4u*)(VS + (r0 + t) * SW + lane * 8);
        const float a0 = bf2f(v.x & 0xffff), a1 = bf2f(v.x >> 16), a2 = bf2f(v.y & 0xffff), a3 = bf2f(v.y >> 16), a4 = bf2f(v.z & 0xffff), a5 = bf2f(v.z >> 16), a6 = bf2f(v.w & 0xffff), a7 = bf2f(v.w >> 16);
        const float ss = wave_sum((a0 * a0 + a1 * a1) + (a2 * a2 + a3 * a3) + (a4 * a4 + a5 * a5) + (a6 * a6 + a7 * a7));
        if (lane == 0) rs[t] = 1.0f / sqrtf(ss * (1.0f / SW) + EPS); }
    __syncthreads();
    LAS unsigned short* vn = (LAS unsigned short*)(lds + g * SG_WAVE_BYTES);
#pragma unroll
    for (int dp = 0; dp < 4; ++dp) { const int d8 = (dp * 2 + hi) * 8;
        const f32x4 g0 = *(const f32x4*)(g_sgu + g * 64 + d8), g1 = *(const f32x4*)(g_sgu + g * 64 + d8 + 4);
#pragma unroll
        for (int sp = 0; sp < 4; ++sp) { const int s = sp * 32 + r32; const v4u v = *(const v4u*)(VS + (r0 + s) * SW + g * 64 + d8); const float rr = rs[s];
            LAS unsigned short* p = vn + d8 * SG_ROW + s;
            p[0 * SG_ROW] = (unsigned short)f2bf(bf2f(v.x & 0xffff) * rr * g0.x); p[1 * SG_ROW] = (unsigned short)f2bf(bf2f(v.x >> 16) * rr * g0.y);
            p[2 * SG_ROW] = (unsigned short)f2bf(bf2f(v.y & 0xffff) * rr * g0.z); p[3 * SG_ROW] = (unsigned short)f2bf(bf2f(v.y >> 16) * rr * g0.w);
            p[4 * SG_ROW] = (unsigned short)f2bf(bf2f(v.z & 0xffff) * rr * g1.x); p[5 * SG_ROW] = (unsigned short)f2bf(bf2f(v.z >> 16) * rr * g1.y);
            p[6 * SG_ROW] = (unsigned short)f2bf(bf2f(v.w & 0xffff) * rr * g1.z); p[7 * SG_ROW] = (unsigned short)f2bf(bf2f(v.w >> 16) * rr * g1.w); } }
    __syncthreads();
    const bf16* wg = WS + (size_t)g * 128 * 128;
#pragma unroll 1
    for (int tt = 0; tt < 4; ++tt) {
        f32x16 z0 = {}, z1 = {};
        const bf16* wrow = wg + (size_t)(32 * tt + r32) * 128 + hi * 8;
        for (int ks = 0; ks < 2 * tt + 2; ++ks) {
            const bf16x8 wb = *(const bf16x8*)(wrow + ks * 16);
            const bf16x8 a0 = *(const LAS bf16x8*)(vn + r32 * SG_ROW + ks * 16 + hi * 8);
            const bf16x8 a1 = *(const LAS bf16x8*)(vn + (32 + r32) * SG_ROW + ks * 16 + hi * 8);
            z0 = __builtin_amdgcn_mfma_f32_32x32x16_bf16(a0, wb, z0, 0, 0, 0);
            z1 = __builtin_amdgcn_mfma_f32_32x32x16_bf16(a1, wb, z1, 0, 0, 0);
        }
        const int t = 32 * tt + r32; const float bs = b_sgu[g * 128 + t];
        const size_t off = (r0 + t) * SW + g * 64 + 4 * hi;
#pragma unroll
        for (int q = 0; q < 4; ++q) {
            { const v2u uu = *(const v2u*)(U + off + 8 * q); v2u o;
              o.x = pk2(bf2f(uu.x & 0xffff) * (z0[4 * q] + bs), bf2f(uu.x >> 16) * (z0[4 * q + 1] + bs)); o.y = pk2(bf2f(uu.y & 0xffff) * (z0[4 * q + 2] + bs), bf2f(uu.y >> 16) * (z0[4 * q + 3] + bs));
              *(v2u*)(O + off + 8 * q) = o; }
            { const v2u uu = *(const v2u*)(U + off + 32 + 8 * q); v2u o;
              o.x = pk2(bf2f(uu.x & 0xffff) * (z1[4 * q] + bs), bf2f(uu.x >> 16) * (z1[4 * q + 1] + bs)); o.y = pk2(bf2f(uu.y & 0xffff) * (z1[4 * q + 2] + bs), bf2f(uu.y >> 16) * (z1[4 * q + 3] + bs));
              *(v2u*)(O + off + 32 + 8 * q) = o; }
        }
    }
    __syncthreads();
}

struct Args { const float* in[16]; float* out; unsigned char* ws; };

__global__ void __launch_bounds__(NWAVES * 64, 2) moba_gmlp_fwd(Args a) {
    extern __shared__ __attribute__((aligned(16))) unsigned char lds_raw[];
    cg::grid_group grid = cg::this_grid();
    LAS unsigned char* lds = (LAS unsigned char*)lds_raw;
    const int tid = threadIdx.x, lane = tid & 63, wave = __builtin_amdgcn_readfirstlane(tid >> 6);
    const int G = gridDim.x, bx = blockIdx.x;
    const int gw = bx * NWAVES + wave, NGW = G * NWAVES;
    const float *x = a.in[0], *c = a.in[1], *w_ada = a.in[2], *b_ada = a.in[3], *g_mix = a.in[4], *w_in = a.in[5], *w_pa = a.in[6], *g_sgu = a.in[7], *w_sgu = a.in[8], *b_sgu = a.in[9],
                *w_ps = a.in[10], *w_out = a.in[11], *g_ffn = a.in[12], *w_ff1 = a.in[13], *w_ff2 = a.in[14], *g_final = a.in[15];
    unsigned char* ws = a.ws; float* out = a.out;
    float* MOD = (float*)(ws + WS_MOD); float* KSUM = (float*)(ws + WS_KSUM);
    bf16 *WSG = (bf16*)(ws + WS_WSGU), *WIN = (bf16*)(ws + WS_WIN), *WPA = (bf16*)(ws + WS_WPA), *WPS = (bf16*)(ws + WS_WPS), *WOUT = (bf16*)(ws + WS_WOUT), *WFF1 = (bf16*)(ws + WS_WFF1), *WFF2 = (bf16*)(ws + WS_WFF2);
    bf16 *Hb = (bf16*)(ws + WS_H), *Qb = (bf16*)(ws + WS_Q), *Kb = (bf16*)(ws + WS_K), *Vb = (bf16*)(ws + WS_V), *Ub = (bf16*)(ws + WS_U), *VSb = (bf16*)(ws + WS_VS), *GAb = (bf16*)(ws + WS_GA), *GBb = (bf16*)(ws + WS_GB),
         *ATTO = (bf16*)(ws + WS_ATTO), *SGUO = (bf16*)(ws + WS_SGUO), *HID = (bf16*)(ws + WS_HID);

    for (int it = bx; it < NMODW / 32; it += G) mod_item(c, w_ada, b_ada, MOD, it, lds, tid);
    {
        LAS float* scr = (LAS float*)(lds + wave * 16384);
        constexpr int I_IN = (DM / 64) * (INW / 32), I_PA = (AW / 64) * (DM / 32), I_PS = (SW / 64) * (DM / 32), I_OUT = (DM / 64) * (DM / 32), I_F1 = (DM / 64) * (DFF / 32), I_F2 = (DFF / 64) * (DM / 32);
        constexpr int NITEMS = I_IN + I_PA + I_PS + I_OUT + I_F1 + I_F2;
        for (int it = gw; it < NITEMS; it += NGW) {
            int r = it;
            if (r < I_IN) { transpose_item(w_in, DM, INW, WIN, scr, r, lane); continue; } r -= I_IN;
            if (r < I_PA) { transpose_item(w_pa, AW, DM, WPA, scr, r, lane); continue; } r -= I_PA;
            if (r < I_PS) { transpose_item(w_ps, SW, DM, WPS, scr, r, lane); continue; } r -= I_PS;
            if (r < I_OUT) { transpose_item(w_out, DM, DM, WOUT, scr, r, lane); continue; } r -= I_OUT;
            if (r < I_F1) { transpose_item(w_ff1, DM, DFF, WFF1, scr, r, lane); continue; } r -= I_F1;
            transpose_item(w_ff2, DFF, DM, WFF2, scr, r, lane);
        }
        for (int i = bx * 512 + tid; i < 8 * 128 * 128; i += G * 512) { const int s = i & 127, t = (i >> 7) & 127; WSG[i] = (unsigned short)f2bf(s <= t ? w_sgu[i] : 0.f); }
    }
    grid.sync();
    norm_rows_bf16(x, Hb, g_mix, MOD, 0, DM, gw, NGW, lane);
    grid.sync();
    { pg8::Gemm g{Hb, WIN, M, INW, DM}; pg8::StaticOrder S; S.init(M, INW, G, bx); pg8::EpiIn E{Qb, KSUM};
      pg8::gemm_phase<pg8::EpiIn, pg8::StaticOrder, true, true>(lds, g, S, E); }
    grid.sync();
    for (int u = bx; u < BATCH * 8; u += G) {
        const int b = u >> 3, h = u & 7;
        for (int qb = 7; qb >= 0; --qb) attn_unit(b, h, qb, Qb, Kb, Vb, ATTO, KSUM, lds, tid);
    }
    for (int u = bx; u < BATCH * 16; u += G) sgu_unit(u >> 4, u & 15, Ub, VSb, SGUO, WSG, g_sgu, b_sgu, lds, tid);
    grid.sync();
    { pg8::Gemm g{ATTO, WPA, M, DM, AW}; pg8::StaticOrder S; S.init(M, DM, G, bx); pg8::EpiMul<0> E{GAb, nullptr};
      pg8::gemm_phase<pg8::EpiMul<0>, pg8::StaticOrder, true, true>(lds, g, S, E); }
    { pg8::Gemm g{SGUO, WPS, M, DM, SW}; pg8::StaticOrder S; S.init(M, DM, G, bx); pg8::EpiMul<1> E{GAb, GBb};
      pg8::gemm_phase<pg8::EpiMul<1>, pg8::StaticOrder, true, true>(lds, g, S, E); }
    grid.sync();
    { pg8::Gemm g{GAb, WOUT, M, DM, DM}; pg8::StaticOrder S; S.init(M, DM, G, bx); pg8::EpiRes E{x, out, MOD + 2 * DM};
      pg8::gemm_phase<pg8::EpiRes, pg8::StaticOrder, true, true>(lds, g, S, E); }
    grid.sync();
    norm_rows_bf16(out, Hb, g_ffn, MOD, 3 * DM, 4 * DM, gw, NGW, lane);
    grid.sync();
    { pg8::Gemm g{Hb, WFF1, M, DFF, DM}; pg8::StaticOrder S; S.init(M, DFF, G, bx); pg8::EpiRelu2 E{HID};
      pg8::gemm_phase<pg8::EpiRelu2, pg8::StaticOrder, true, true>(lds, g, S, E); }
    grid.sync();
    { pg8::Gemm g{HID, WFF2, M, DM, DFF}; pg8::StaticOrder S; S.init(M, DM, G, bx); pg8::EpiRes E{out, out, MOD + 5 * DM};
      pg8::gemm_phase<pg8::EpiRes, pg8::StaticOrder, true, true>(lds, g, S, E); }
    grid.sync();
    norm_rows_final(out, g_final, gw, NGW, lane);
}

extern "C" void kernel_launch(void* const* d_in, const int* in_sizes, int n_in, void* d_out, int out_size, void* d_ws, size_t ws_size, hipStream_t stream) {
    static int grid = 0;
    if (grid == 0) {
        if (n_in != 16 || in_sizes[0] != M * DM || out_size != M * DM || ws_size < WS_END) { fprintf(stderr, "kernel_launch: unexpected shapes / workspace (n_in %d, in0 %d, out %d, ws %zu); nothing launched\n", n_in, n_in > 0 ? in_sizes[0] : -1, out_size, ws_size); grid = -1; return; }
        int dev = 0, cus = 0, per_cu = 0;
        hipGetDevice(&dev); hipDeviceGetAttribute(&cus, hipDeviceAttributeMultiprocessorCount, dev);
        if (hipFuncSetAttribute((const void*)moba_gmlp_fwd, hipFuncAttributeMaxDynamicSharedMemorySize, LDS_BYTES) != hipSuccess) { fprintf(stderr, "kernel_launch: hipFuncSetAttribute failed\n"); grid = -1; return; }
        if (hipOccupancyMaxActiveBlocksPerMultiprocessor(&per_cu, (const void*)moba_gmlp_fwd, NWAVES * 64, LDS_BYTES) != hipSuccess || per_cu < 1) { fprintf(stderr, "kernel_launch: occupancy query says %d blocks per CU\n", per_cu); (void)hipGetLastError(); grid = -1; return; }
        grid = cus * 1;
    }
    if (grid < 0) return;
    Args a{};
    for (int i = 0; i < 16; ++i) a.in[i] = (const float*)d_in[i];
    a.out = (float*)d_out; a.ws = (unsigned char*)d_ws;
    void* args[] = {&a};
    hipError_t e = hipLaunchCooperativeKernel((const void*)moba_gmlp_fwd, dim3(grid), dim3(NWAVES * 64), args, LDS_BYTES, stream);
    if (e != hipSuccess) fprintf(stderr, "cooperative launch failed: %s (grid %d)\n", hipGetErrorString(e), grid);
}
```

```cpp
#include <hip/hip_runtime.h>
#include <hip/hip_cooperative_groups.h>
#include <cstdio>
#include <cstdint>
#include <cmath>
namespace pg8 {
#define PG8_LAS __attribute__((address_space(3)))
typedef unsigned short bf16_t;
typedef short bf16x8 __attribute__((ext_vector_type(8)));
typedef float f32x4 __attribute__((ext_vector_type(4)));
typedef unsigned u32x4 __attribute__((ext_vector_type(4)));
constexpr int BM = 256, BK = 64, HALF = 128, HTB = HALF * BK * 2  , STAGE_BYTES = 8 * HTB, NXCD = 8, WGM = 8;

__host__ __device__ __forceinline__ int lds_byte(int r, int c) { const int st = (r >> 4) * 2 + (c >> 5), rr = r & 15, cc = c & 31, ob = rr * 64 + cc * 2; return st * 1024 + (ob ^ (((ob >> 9) & 1) << 5)); }
__host__ __device__ __forceinline__ void stage_rc(int b, int& R, int& C) { const int st = b / 1024, sb = b % 1024, swz = sb ^ (((sb >> 9) & 1) << 5); R = (st >> 1) * 16 + swz / 64; C = (st & 1) * 32 + (swz % 64) / 2; }
__host__ __device__ __forceinline__ int perm32(int rho) { const int n = rho >> 4, i = rho & 15; return 8 * (i >> 2) + 4 * n + (i & 3); }

struct Unit { int pm, pn; };
struct Gemm { const bf16_t* A; const bf16_t* Bt; int M, N, K; };

struct StaticOrder {
    int nM, nN, nwg, G, c;
    __host__ __device__ void init(int M, int N, int G_, int c_) { nM = M / BM; nN = N / BM; nwg = nM * nN; G = G_; c = c_; }
    __host__ __device__ bool next(int i, Unit& u) const {
        const long L = (long)i * G + c; if (L >= nwg) return false;
        int wgid = (int)L; { const int q = nwg / NXCD, r = nwg % NXCD, xcd = wgid % NXCD, off = wgid / NXCD; wgid = (xcd < r ? xcd * (q + 1) : r * (q + 1) + (xcd - r) * q) + off; }
        const int nig = WGM * nN, gid = wgid / nig, fm = gid * WGM, gsz = (nM - fm) < WGM ? (nM - fm) : WGM;
        u.pm = fm + ((wgid % nig) % gsz); u.pn = (wgid % nig) / gsz; return true;
    }
    __device__ __forceinline__ void a_ready(const Unit&) const {}
    __device__ __forceinline__ void done(const Unit&) const {}
};
__device__ __forceinline__ unsigned cvt_pk_bf16(float lo, float hi) { unsigned r; asm volatile("v_cvt_pk_bf16_f32 %0, %1, %2" : "=v"(r) : "v"(lo), "v"(hi)); return r; }
typedef float f32x2 __attribute__((ext_vector_type(2)));
constexpr int MROWS = 65536;
constexpr float QSCALE = 0.125f * 1.4426950408889634f;
__device__ __forceinline__ float bf2f(unsigned short b) { return __builtin_bit_cast(float, (unsigned)b << 16); }
__device__ __forceinline__ float gelu_tanh_f(float x) {
    const float y = x * (1.0f + 0.044715f * x * x) * (-1.5957691216057308f * 1.4426950408889634f);
    return x * __builtin_amdgcn_rcpf(1.0f + __builtin_amdgcn_exp2f(y));
}
__device__ __forceinline__ float sigmoid_f(float x) { return __builtin_amdgcn_rcpf(1.0f + __builtin_amdgcn_exp2f(x * -1.4426950408889634f)); }

struct EpiIn {
    static constexpr bool PERM = true, AFTER_DRAIN = false;
    bf16_t* base0; float* ksum;
    __device__ __forceinline__ void operator()(const f32x4 (&acc)[2][2][4][2], const Unit& u, int wr, int wc, int fr, int fq) const {
        const int pn = u.pn; int kind, ldc, colt; size_t boff;
        if (pn < 10) { const int t = pn >> 1; boff = (size_t)t * MROWS * 512; ldc = 512; colt = (pn & 1) * 256; kind = (t == 0) ? 0 : (t < 3 ? 1 : 2); }
        else { const int t = (pn - 10) >> 2; boff = (size_t)5 * MROWS * 512 + (size_t)t * MROWS * 1024; ldc = 1024; colt = ((pn - 10) & 3) * 256; kind = 3; }
        bf16_t* base = base0 + boff;
        const int row0 = u.pm * BM + wr * 64 + fr, col0 = colt + wc * 32 + 8 * fq;
        if (pn == 2 || pn == 3) {
            float* kp = ksum + ((size_t)u.pm * 2 + wr) * 512 + col0;
#pragma unroll
            for (int bj = 0; bj < 2; ++bj)
#pragma unroll
                for (int n = 0; n < 2; ++n)
#pragma unroll
                    for (int i = 0; i < 4; ++i) {
                        float s = 0.f;
#pragma unroll
                        for (int ai = 0; ai < 2; ++ai)
#pragma unroll
                            for (int m = 0; m < 4; ++m) s += acc[ai][bj][m][n][i];
                        s += __shfl_xor(s, 1); s += __shfl_xor(s, 2); s += __shfl_xor(s, 4); s += __shfl_xor(s, 8);
                        if (fr == 0) kp[bj * HALF + 4 * n + i] = s;
                    }
        }
#pragma unroll
        for (int ai = 0; ai < 2; ++ai)
#pragma unroll
            for (int m = 0; m < 4; ++m) { bf16_t* rowp = base + (size_t)(row0 + ai * HALF + m * 16) * ldc + col0;
#pragma unroll
                for (int bj = 0; bj < 2; ++bj) { f32x4 v0 = acc[ai][bj][m][0], v1 = acc[ai][bj][m][1];
                    if (kind == 0) { v0 = v0 * QSCALE; v1 = v1 * QSCALE; }
                    else if (kind == 2) {
#pragma unroll
                        for (int i = 0; i < 4; ++i) { v0[i] = gelu_tanh_f(v0[i]); v1[i] = gelu_tanh_f(v1[i]); } }
                    else if (kind == 3) {
#pragma unroll
                        for (int i = 0; i < 4; ++i) { v0[i] = sigmoid_f(v0[i]); v1[i] = sigmoid_f(v1[i]); } }
                    u32x4 w; w.x = cvt_pk_bf16(v0[0], v0[1]); w.y = cvt_pk_bf16(v0[2], v0[3]); w.z = cvt_pk_bf16(v1[0], v1[1]); w.w = cvt_pk_bf16(v1[2], v1[3]);
                    *(u32x4*)(rowp + bj * HALF) = w; } }
    }
};
template <int MODE> struct EpiMul {
    static constexpr bool PERM = true, AFTER_DRAIN = false;
    bf16_t* G; const bf16_t* Hh;
    __device__ __forceinline__ void operator()(const f32x4 (&acc)[2][2][4][2], const Unit& u, int wr, int wc, int fr, int fq) const {
        const int row0 = u.pm * BM + wr * 64 + fr, col0 = u.pn * BM + wc * 32 + 8 * fq;
#pragma unroll
        for (int ai = 0; ai < 2; ++ai)
#pragma unroll
            for (int m = 0; m < 4; ++m) { const size_t off = (size_t)(row0 + ai * HALF + m * 16) * 1024 + col0;
#pragma unroll
                for (int bj = 0; bj < 2; ++bj) { const f32x4 a0 = acc[ai][bj][m][0], a1 = acc[ai][bj][m][1];
                    const u32x4 g = *(const u32x4*)(G + off + bj * HALF); float r[8];
                    const float gf[8] = {bf2f(g.x & 0xffff), bf2f(g.x >> 16), bf2f(g.y & 0xffff), bf2f(g.y >> 16), bf2f(g.z & 0xffff), bf2f(g.z >> 16), bf2f(g.w & 0xffff), bf2f(g.w >> 16)};
                    if (MODE == 0) {
#pragma unroll
                        for (int i = 0; i < 4; ++i) { r[i] = gf[i] * a0[i]; r[4 + i] = gf[4 + i] * a1[i]; }
                    } else {
                        const u32x4 h = *(const u32x4*)(Hh + off + bj * HALF);
                        const float hf[8] = {bf2f(h.x & 0xffff), bf2f(h.x >> 16), bf2f(h.y & 0xffff), bf2f(h.y >> 16), bf2f(h.z & 0xffff), bf2f(h.z >> 16), bf2f(h.w & 0xffff), bf2f(h.w >> 16)};
#pragma unroll
                        for (int i = 0; i < 4; ++i) { r[i] = gf[i] + hf[i] * a0[i]; r[4 + i] = gf[4 + i] + hf[4 + i] * a1[i]; }
                    }
                    u32x4 w; w.x = cvt_pk_bf16(r[0], r[1]); w.y = cvt_pk_bf16(r[2], r[3]); w.z = cvt_pk_bf16(r[4], r[5]); w.w = cvt_pk_bf16(r[6], r[7]);
                    *(u32x4*)(G + off + bj * HALF) = w; } }
    }
};
struct EpiRes {
    static constexpr bool PERM = false, AFTER_DRAIN = false;
    const float* base; float* out; const float* gate;
    __device__ __forceinline__ void operator()(const f32x4 (&acc)[2][2][4][2], const Unit& u, int wr, int wc, int fr, int fq) const {
        const int row0 = u.pm * BM + wr * 64 + fr, col0 = u.pn * BM + wc * 32 + 4 * fq;
        const float* gp = gate + (size_t)(u.pm >> 3) * 6144 + col0;
#pragma unroll
        for (int bj = 0; bj < 2; ++bj)
#pragma unroll
            for (int n = 0; n < 2; ++n) { const f32x4 gv = *(const f32x4*)(gp + bj * HALF + n * 16);
#pragma unroll
                for (int ai = 0; ai < 2; ++ai)
#pragma unroll
                    for (int m = 0; m < 4; ++m) { const size_t off = (size_t)(row0 + ai * HALF + m * 16) * 1024 + col0 + bj * HALF + n * 16;
                        const f32x4 bs = *(const f32x4*)(base + off); *(f32x4*)(out + off) = bs + gv * acc[ai][bj][m][n]; } }
    }
};
struct EpiRelu2 {
    static constexpr bool PERM = true, AFTER_DRAIN = false;
    bf16_t* O;
    __device__ __forceinline__ void operator()(const f32x4 (&acc)[2][2][4][2], const Unit& u, int wr, int wc, int fr, int fq) const {
        const int row0 = u.pm * BM + wr * 64 + fr, col0 = u.pn * BM + wc * 32 + 8 * fq;
#pragma unroll
        for (int ai = 0; ai < 2; ++ai)
#pragma unroll
            for (int m = 0; m < 4; ++m) { bf16_t* rowp = O + (size_t)(row0 + ai * HALF + m * 16) * 4096 + col0;
#pragma unroll
                for (int bj = 0; bj < 2; ++bj) { f32x4 v0 = acc[ai][bj][m][0], v1 = acc[ai][bj][m][1];
#pragma unroll
                    for (int i = 0; i < 4; ++i) { const float a = fmaxf(v0[i], 0.f), b = fmaxf(v1[i], 0.f); v0[i] = a * a; v1[i] = b * b; }
                    u32x4 w; w.x = cvt_pk_bf16(v0[0], v0[1]); w.y = cvt_pk_bf16(v0[2], v0[3]); w.z = cvt_pk_bf16(v1[0], v1[1]); w.w = cvt_pk_bf16(v1[2], v1[3]);
                    *(u32x4*)(rowp + bj * HALF) = w; } }
    }
};
template <class Epi, class Sched, bool ALIGN_EPI = false, bool SP2 = false>
__device__ __forceinline__ void gemm_phase(PG8_LAS unsigned char* lds, const Gemm g, const Sched& S, const Epi& E) {
    const int tid = threadIdx.x, wid = __builtin_amdgcn_readfirstlane(tid >> 6), lane = tid & 63, wr = wid >> 2, wc = wid & 3, fr = lane & 15, fq = lane >> 4;
    const int K = g.K, nt = K / BK;
    unsigned voffA[2], voffB[2];
#pragma unroll
    for (int i = 0; i < 2; ++i) { int R, C; stage_rc(tid * 16 + i * 8192, R, C); const int Rb = Epi::PERM ? ((R & ~31) + perm32(R & 31)) : R;
        voffA[i] = (unsigned)(R * K + C) * 2u; voffB[i] = (unsigned)(Rb * K + C) * 2u; }
    const size_t kstep = (size_t)(BK * 2);
    const size_t hstep = (size_t)HALF * K * 2;
    const size_t tstep = 2 * hstep;
    const unsigned ldsw = (unsigned)wid * 1024u;
    const int aoff = lds_byte(wr * 64 + fr, fq * 8), boff = lds_byte(wc * 32 + fr, fq * 8);
#define PG8_SA(b, h) (((b) * 2 + (h)) * HTB)
#define PG8_SB(b, h) ((4 + (b) * 2 + (h)) * HTB)
#define PG8_STAGE(bufoff, gbase, voff) do { _Pragma("unroll") for (int _i = 0; _i < 2; ++_i) \
        __builtin_amdgcn_global_load_lds((const unsigned*)((const char*)(gbase) + (voff)[_i]), (PG8_LAS unsigned*)(lds + (bufoff) + ldsw + _i * 8192), 16, 0, 0); } while (0)
#define PG8_LDA(dst, b, h) do { _Pragma("unroll") for (int m = 0; m < 4; ++m) _Pragma("unroll") for (int k = 0; k < 2; ++k) dst[m][k] = *(const PG8_LAS bf16x8*)(lds + PG8_SA(b, h) + aoff + m * 2048 + k * 1024); } while (0)
#define PG8_LDB(dst, b, h) do { _Pragma("unroll") for (int n = 0; n < 2; ++n) _Pragma("unroll") for (int k = 0; k < 2; ++k) dst[n][k] = *(const PG8_LAS bf16x8*)(lds + PG8_SB(b, h) + boff + n * 2048 + k * 1024); } while (0)
#define PG8_MMA(ai, bj, At, Bt) do { __builtin_amdgcn_s_setprio(1); _Pragma("unroll") for (int m = 0; m < 4; ++m) _Pragma("unroll") for (int n = 0; n < 2; ++n) _Pragma("unroll") for (int k = 0; k < 2; ++k) \
        acc[ai][bj][m][n] = __builtin_amdgcn_mfma_f32_16x16x32_bf16(Bt[n][k], At[m][k], acc[ai][bj][m][n], 0, 0, 0); __builtin_amdgcn_s_setprio(0); } while (0)
#define PG8_WAIT_V(n) asm volatile("s_waitcnt vmcnt(" #n ")" ::: "memory")
#define PG8_WAIT_L(n) asm volatile("s_waitcnt lgkmcnt(" #n ")" ::: "memory")
#define PG8_BAR __builtin_amdgcn_s_barrier()
#define PG8_SCHED __builtin_amdgcn_sched_barrier(0)
    Unit cur, nxt; int ui = 0;
    if (!S.next(0, cur)) return;
    f32x4 acc[2][2][4][2];
#pragma unroll
    for (int a = 0; a < 2; ++a)
#pragma unroll
        for (int b = 0; b < 2; ++b)
#pragma unroll
            for (int m = 0; m < 4; ++m)
#pragma unroll
                for (int n = 0; n < 2; ++n) acc[a][b][m][n] = (f32x4){0.f, 0.f, 0.f, 0.f};
    bf16x8 At[4][2], B0[2][2], B1[2][2];
    const char* cA = (const char*)g.A + (size_t)cur.pm * tstep; const char* cB = (const char*)g.Bt + (size_t)cur.pn * tstep;
    S.a_ready(cur);
    if constexpr (SP2) {
        PG8_STAGE(PG8_SB(0, 0), cB, voffB); PG8_STAGE(PG8_SB(0, 1), cB + hstep, voffB); PG8_STAGE(PG8_SA(0, 0), cA, voffA); PG8_STAGE(PG8_SA(0, 1), cA + hstep, voffA);
        if (wr == 1) PG8_BAR;
        PG8_WAIT_V(2); PG8_BAR;
        PG8_STAGE(PG8_SB(1, 0), cB + kstep, voffB); PG8_STAGE(PG8_SA(1, 0), cA + kstep, voffA); PG8_STAGE(PG8_SB(1, 1), cB + hstep + kstep, voffB);
        PG8_WAIT_V(6); PG8_BAR;
    } else {
        PG8_STAGE(PG8_SB(0, 0), cB, voffB); PG8_STAGE(PG8_SA(0, 0), cA, voffA); PG8_STAGE(PG8_SB(0, 1), cB + hstep, voffB); PG8_STAGE(PG8_SA(0, 1), cA + hstep, voffA);
        if (wr == 1) PG8_BAR;
        PG8_WAIT_V(4); PG8_BAR;
        PG8_STAGE(PG8_SB(1, 0), cB + kstep, voffB); PG8_STAGE(PG8_SA(1, 0), cA + kstep, voffA); PG8_STAGE(PG8_SB(1, 1), cB + hstep + kstep, voffB);
        PG8_WAIT_V(6); PG8_BAR;
    }
    for (;;) {
        const bool has_next = S.next(ui + 1, nxt);
        const char* nA = has_next ? (const char*)g.A + (size_t)nxt.pm * tstep : cA; const char* nB = has_next ? (const char*)g.Bt + (size_t)nxt.pn * tstep : cB;
        for (int t = 0; t < nt; t += 2) {
            const bool last = (t == nt - 2);
            const char* a1 = cA + (size_t)(t + 1) * kstep;
            const char* a2 = last ? nA : cA + (size_t)(t + 2) * kstep; const char* b2 = last ? nB : cB + (size_t)(t + 2) * kstep;
            const char* a3 = a2 + kstep; const char* b3 = b2 + kstep;
            if (last && has_next) S.a_ready(nxt);
            if constexpr (SP2) {
            PG8_LDB(B0, 0, 0); PG8_LDB(B1, 0, 1); PG8_SCHED; PG8_LDA(At, 0, 0); PG8_STAGE(PG8_SA(1, 1), a1 + hstep, voffA);
            PG8_WAIT_V(8); PG8_WAIT_L(0); PG8_BAR; PG8_MMA(0, 0, At, B0); PG8_MMA(0, 1, At, B1); PG8_BAR; PG8_SCHED;
            PG8_LDA(At, 0, 1); PG8_STAGE(PG8_SB(0, 0), b2, voffB); PG8_STAGE(PG8_SB(0, 1), b2 + hstep, voffB); PG8_STAGE(PG8_SA(0, 0), a2, voffA);
            PG8_WAIT_V(8); PG8_WAIT_L(0); PG8_BAR; PG8_MMA(1, 0, At, B0); PG8_MMA(1, 1, At, B1); PG8_BAR; PG8_SCHED;
            PG8_LDB(B0, 1, 0); PG8_LDB(B1, 1, 1); PG8_SCHED; PG8_LDA(At, 1, 0); PG8_STAGE(PG8_SA(0, 1), a2 + hstep, voffA);
            PG8_WAIT_V(8); PG8_WAIT_L(0); PG8_BAR; PG8_MMA(0, 0, At, B0); PG8_MMA(0, 1, At, B1); PG8_BAR; PG8_SCHED;
            PG8_LDA(At, 1, 1); PG8_STAGE(PG8_SB(1, 0), b3, voffB); PG8_STAGE(PG8_SB(1, 1), b3 + hstep, voffB); PG8_STAGE(PG8_SA(1, 0), a3, voffA);
            PG8_WAIT_V(8); PG8_WAIT_L(0); PG8_BAR; PG8_MMA(1, 0, At, B0); PG8_MMA(1, 1, At, B1); PG8_BAR; PG8_SCHED;
            } else {
            PG8_LDB(B0, 0, 0); PG8_SCHED; PG8_LDA(At, 0, 0); PG8_STAGE(PG8_SA(1, 1), a1 + hstep, voffA);
            PG8_WAIT_L(8); PG8_BAR; PG8_WAIT_L(0); PG8_MMA(0, 0, At, B0); PG8_BAR; PG8_SCHED;
            PG8_LDB(B1, 0, 1); PG8_STAGE(PG8_SB(0, 0), b2, voffB);
            PG8_BAR; PG8_WAIT_L(0); PG8_MMA(0, 1, At, B1); PG8_BAR;
            PG8_LDA(At, 0, 1); PG8_STAGE(PG8_SA(0, 0), a2, voffA);
            PG8_BAR; PG8_WAIT_L(0); PG8_MMA(1, 0, At, B0); PG8_BAR; PG8_SCHED;
            PG8_STAGE(PG8_SB(0, 1), b2 + hstep, voffB);
            PG8_WAIT_V(6); PG8_BAR; PG8_MMA(1, 1, At, B1); PG8_BAR;
            PG8_LDB(B0, 1, 0); PG8_SCHED; PG8_LDA(At, 1, 0); PG8_STAGE(PG8_SA(0, 1), a2 + hstep, voffA);
            PG8_WAIT_L(8); PG8_BAR; PG8_WAIT_L(0); PG8_MMA(0, 0, At, B0); PG8_BAR; PG8_SCHED;
            PG8_LDB(B1, 1, 1); PG8_STAGE(PG8_SB(1, 0), b3, voffB);
            PG8_BAR; PG8_WAIT_L(0); PG8_MMA(0, 1, At, B1); PG8_BAR;
            PG8_LDA(At, 1, 1); PG8_STAGE(PG8_SA(1, 0), a3, voffA);
            PG8_BAR; PG8_WAIT_L(0); PG8_MMA(1, 0, At, B0); PG8_BAR; PG8_SCHED;
            PG8_STAGE(PG8_SB(1, 1), b3 + hstep, voffB);
            PG8_WAIT_V(6); PG8_BAR; PG8_MMA(1, 1, At, B1); PG8_BAR;
            }
        }
        if constexpr (ALIGN_EPI) { if (wr == 0) PG8_BAR; }
        if constexpr (!Epi::AFTER_DRAIN) { E(acc, cur, wr, wc, fr, fq); S.done(cur); }
        if (!has_next) break;
#pragma unroll
        for (int a = 0; a < 2; ++a)
#pragma unroll
            for (int b = 0; b < 2; ++b)
#pragma unroll
                for (int m = 0; m < 4; ++m)
#pragma unroll
                    for (int n = 0; n < 2; ++n) acc[a][b][m][n] = (f32x4){0.f, 0.f, 0.f, 0.f};
        cur = nxt; cA = nA; cB = nB; ++ui;
        if constexpr (ALIGN_EPI) { if (wr == 1) PG8_BAR; }
    }
    PG8_WAIT_V(0);
    if constexpr (!ALIGN_EPI) { if (wr == 0) PG8_BAR; }
    PG8_BAR;
    if constexpr (Epi::AFTER_DRAIN) { E.fused(acc, cur, wr, wc, fr, fq, lds, wid, lane); S.done(cur); }
#undef PG8_SA
#undef PG8_SB
#undef PG8_STAGE
#undef PG8_LDA
#undef PG8_LDB
#undef PG8_MMA
#undef PG8_WAIT_V
#undef PG8_WAIT_L
#undef PG8_BAR
#undef PG8_SCHED
}
}

namespace cg = cooperative_groups;
#define LAS __attribute__((address_space(3)))
typedef unsigned short bf16;
typedef unsigned v4u __attribute__((ext_vector_type(4)));
typedef unsigned v2u __attribute__((ext_vector_type(2)));
typedef float f32x4 __attribute__((ext_vector_type(4)));
typedef float f32x16 __attribute__((ext_vector_type(16)));
typedef short bf16x8 __attribute__((ext_vector_type(8)));
typedef short s16x4 __attribute__((ext_vector_type(4)));

constexpr int BATCH = 32, SEQ = 2048, DM = 1024, M = BATCH * SEQ, AW = 512, SW = 512, INW = 4608, DFF = 4096, NMODW = 6 * DM;
constexpr float EPS = 1e-6f;
constexpr int NWAVES = 8, LDS_BYTES = 147456;
constexpr size_t MiB = 1u << 20;
constexpr size_t WS_MOD = 1 * MiB, WS_KSUM = 2 * MiB, WS_WSGU = 3 * MiB, WS_WIN = 4 * MiB, WS_WPA = 13 * MiB, WS_WPS = 14 * MiB, WS_WOUT = 15 * MiB, WS_WFF1 = 17 * MiB, WS_WFF2 = 25 * MiB;
constexpr size_t WS_H = 64 * MiB, WS_Q = 192 * MiB, WS_K = 256 * MiB, WS_V = 320 * MiB, WS_U = 384 * MiB, WS_VS = 448 * MiB, WS_GA = 512 * MiB, WS_GB = 640 * MiB, WS_ATTO = 768 * MiB, WS_SGUO = 832 * MiB, WS_END = 896 * MiB;
constexpr size_t WS_HID = 192 * MiB;

__device__ __forceinline__ unsigned f2bf(float f) { unsigned u = __builtin_bit_cast(unsigned, f); return (u + 0x7fffu + ((u >> 16) & 1u)) >> 16; }
__device__ __forceinline__ unsigned pk2(float lo, float hi) { unsigned r; asm volatile("v_cvt_pk_bf16_f32 %0, %1, %2" : "=v"(r) : "v"(lo), "v"(hi)); return r; }
__device__ __forceinline__ float bf2f(unsigned short b) { return __builtin_bit_cast(float, (unsigned)b << 16); }
__device__ __forceinline__ float wave_sum(float v) {
#pragma unroll
    for (int o = 1; o < 64; o <<= 1) v += __shfl_xor(v, o);
    return v;
}
#define LDS_WAIT() asm volatile("s_waitcnt lgkmcnt(0)" ::: "memory")

__device__ __forceinline__ void transpose_item(const float* W, int K, int N, bf16* WT, LAS float* scr, int item, int lane) {
    const int nblk = N / 32, kb = item / nblk, nb = item % nblk, k0 = 64 * kb, n0 = 32 * nb;
#pragma unroll 8
    for (int i = 0; i < 32; ++i) { const int kk = 2 * i + (lane >> 5); scr[kk * 33 + (lane & 31)] = W[(size_t)(k0 + kk) * N + n0 + (lane & 31)]; }
    LDS_WAIT(); asm volatile("" ::: "memory");
    const int c = lane & 7;
#pragma unroll
    for (int j = 0; j < 4; ++j) { const int n = (lane >> 3) + 8 * j; const LAS float* s = scr + (8 * c) * 33 + n;
        v4u o; o.x = pk2(s[0 * 33], s[1 * 33]); o.y = pk2(s[2 * 33], s[3 * 33]); o.z = pk2(s[4 * 33], s[5 * 33]); o.w = pk2(s[6 * 33], s[7 * 33]);
        *(v4u*)(WT + (size_t)(n0 + n) * K + k0 + 8 * c) = o; }
    LDS_WAIT(); asm volatile("" ::: "memory");
}

__device__ __forceinline__ void norm_rows_bf16(const float* src, bf16* dst, const float* g, const float* mod, int shift_off, int scale_off, int gw, int NGW, int lane) {
    for (int m = gw; m < M; m += NGW) {
        const int b = m >> 11;
        const f32x4* xr = (const f32x4*)(src + (size_t)m * DM) + lane;
        f32x4 v[4]; float ss = 0.f;
#pragma unroll
        for (int j = 0; j < 4; ++j) { v[j] = xr[64 * j]; ss += (v[j].x * v[j].x + v[j].y * v[j].y) + (v[j].z * v[j].z + v[j].w * v[j].w); }
        const float rstd = 1.0f / sqrtf(wave_sum(ss) * (1.0f / DM) + EPS);
        const float* mb = mod + (size_t)b * NMODW;
        v2u* o8 = (v2u*)(dst + (size_t)m * DM) + lane;
#pragma unroll
        for (int j = 0; j < 4; ++j) { const int col = 4 * lane + 256 * j;
            const f32x4 gg = *(const f32x4*)(g + col), sc = *(const f32x4*)(mb + scale_off + col), sh = *(const f32x4*)(mb + shift_off + col);
            const f32x4 h = v[j] * rstd * gg * (sc + 1.0f) + sh;
            v2u w; w.x = pk2(h.x, h.y); w.y = pk2(h.z, h.w); o8[64 * j] = w; }
    }
}
__device__ __forceinline__ void norm_rows_final(float* x, const float* g, int gw, int NGW, int lane) {
    for (int m = gw; m < M; m += NGW) {
        f32x4* xr = (f32x4*)(x + (size_t)m * DM) + lane;
        f32x4 v[4]; float ss = 0.f;
#pragma unroll
        for (int j = 0; j < 4; ++j) { v[j] = xr[64 * j]; ss += (v[j].x * v[j].x + v[j].y * v[j].y) + (v[j].z * v[j].z + v[j].w * v[j].w); }
        const float rstd = 1.0f / sqrtf(wave_sum(ss) * (1.0f / DM) + EPS);
#pragma unroll
        for (int j = 0; j < 4; ++j) { const f32x4 gg = *(const f32x4*)(g + 4 * lane + 256 * j); xr[64 * j] = v[j] * rstd * gg; }
    }
}

__device__ __forceinline__ void mod_item(const float* c, const float* w_ada, const float* b_ada, float* mod, int item, LAS unsigned char* lds, int tid) {
    LAS float* cat = (LAS float*)lds;
    for (int idx = tid; idx < BATCH * DM; idx += 512) { const int b = idx >> 10, k = idx & 1023; const float v = c[idx]; cat[b * 1028 + k] = v / (1.0f + expf(-v)); }
    __syncthreads();
    const int col = tid & 31, kp = tid >> 5, n0 = item * 32;
    float acc[32];
#pragma unroll
    for (int b = 0; b < 32; ++b) acc[b] = 0.f;
    for (int kk = 0; kk < 64; kk += 4) {
        const int k = kp * 64 + kk;
        const float* wp = w_ada + (size_t)k * NMODW + n0 + col;
        const float w0 = wp[0], w1 = wp[NMODW], w2 = wp[2 * NMODW], w3 = wp[3 * NMODW];
#pragma unroll
        for (int b = 0; b < 32; ++b) { const f32x4 cv = *(const LAS f32x4*)(cat + b * 1028 + k); acc[b] += (cv.x * w0 + cv.y * w1) + (cv.z * w2 + cv.w * w3); }
    }
    __syncthreads();
    LAS float* red = (LAS float*)lds;
#pragma unroll
    for (int b = 0; b < 32; ++b) red[(kp * 32 + b) * 32 + col] = acc[b];
    __syncthreads();
#pragma unroll
    for (int j = 0; j < 2; ++j) { const int o = tid + 512 * j, b = o >> 5, cc = o & 31; float s = 0.f;
#pragma unroll
        for (int q = 0; q < 16; ++q) s += red[(q * 32 + b) * 32 + cc];
        mod[(size_t)b * NMODW + n0 + cc] = s + b_ada[n0 + cc]; }
    __syncthreads();
}

__device__ __forceinline__ int crow(int r, int hi) { return (r & 3) + 8 * (r >> 2) + 4 * hi; }

constexpr int AT_KROW = 72;
constexpr int AT_KT = 0, AT_VT = 2 * 64 * AT_KROW * 2, AT_KMS = 2 * AT_VT;
__device__ __forceinline__ void attn_unit(int b, int h, int qb, const bf16* Q, const bf16* K, const bf16* V, bf16* O, const float* KSUM, LAS unsigned char* lds, int tid) {
    const int lane = tid & 63, w = __builtin_amdgcn_readfirstlane(tid >> 6), r32 = lane & 31, hi = lane >> 5;
    LAS float* kms = (LAS float*)(lds + AT_KMS);
    const size_t rowbase = (size_t)b * SEQ;
    { const int n = tid >> 6, d = tid & 63; const float* p = KSUM + ((size_t)(b * 8 + n) * 2) * 512 + h * 64 + d; kms[n * 64 + d] = p[0] + p[512]; }
    const int qrel = w * 32 + r32;
    const bf16* qp = Q + (rowbase + qb * 256 + qrel) * AW + h * 64;
    bf16x8 qr[4];
#pragma unroll
    for (int ds = 0; ds < 4; ++ds) qr[ds] = *(const bf16x8*)(qp + ds * 16 + hi * 8);
    __syncthreads();
    unsigned sel = 0u;
    if (qb <= 3) sel = (1u << qb) - 1u;
    else {
        float gt[8];
#pragma unroll
        for (int n = 0; n < 8; ++n) { float s = 0.f;
#pragma unroll
            for (int ds = 0; ds < 4; ++ds) { const f32x4 k0 = *(const LAS f32x4*)(kms + n * 64 + ds * 16 + hi * 8), k1 = *(const LAS f32x4*)(kms + n * 64 + ds * 16 + hi * 8 + 4);
                s += bf2f((unsigned short)qr[ds][0]) * k0.x + bf2f((unsigned short)qr[ds][1]) * k0.y + bf2f((unsigned short)qr[ds][2]) * k0.z + bf2f((unsigned short)qr[ds][3]) * k0.w
                   + bf2f((unsigned short)qr[ds][4]) * k1.x + bf2f((unsigned short)qr[ds][5]) * k1.y + bf2f((unsigned short)qr[ds][6]) * k1.z + bf2f((unsigned short)qr[ds][7]) * k1.w; }
            gt[n] = s + __shfl_xor(s, 32); }
#pragma unroll
        for (int rnd = 0; rnd < 3; ++rnd) { float best = -INFINITY; int bi = 0;
#pragma unroll
            for (int n = 0; n < 8; ++n) { const bool ok = (n < qb) && !((sel >> n) & 1u) && (gt[n] > best); best = ok ? gt[n] : best; bi = ok ? n : bi; }
            sel |= 1u << bi; }
    }
    const int ntiles = 4 * (qb + 1);
    const bf16* kg = K + (rowbase + (tid >> 3)) * AW + h * 64 + (tid & 7) * 8;
    const bf16* vg = V + (rowbase + lane) * AW + h * 64 + w * 8;
    v4u kreg = *(const v4u*)(kg + (size_t)(qb * 256) * AW), vreg = *(const v4u*)(vg + (size_t)(qb * 256) * AW);
    float mrun = -INFINITY, lrun = 0.f; f32x16 o0 = {}, o1 = {};
    for (int it = 0; it < ntiles; ++it) {
        const int buf = it & 1;
        LAS unsigned char* kt = lds + AT_KT + buf * (64 * AT_KROW * 2); LAS unsigned char* vt = lds + AT_VT + buf * (64 * AT_KROW * 2);
        *(LAS v4u*)(kt + (tid >> 3) * (AT_KROW * 2) + (tid & 7) * 16) = kreg;
        { LAS unsigned short* vp = (LAS unsigned short*)vt + (w * 8) * AT_KROW + lane;
          vp[0 * AT_KROW] = (unsigned short)(vreg.x & 0xffff); vp[1 * AT_KROW] = (unsigned short)(vreg.x >> 16); vp[2 * AT_KROW] = (unsigned short)(vreg.y & 0xffff); vp[3 * AT_KROW] = (unsigned short)(vreg.y >> 16);
          vp[4 * AT_KROW] = (unsigned short)(vreg.z & 0xffff); vp[5 * AT_KROW] = (unsigned short)(vreg.z >> 16); vp[6 * AT_KROW] = (unsigned short)(vreg.w & 0xffff); vp[7 * AT_KROW] = (unsigned short)(vreg.w >> 16); }
        __syncthreads();
        if (it + 1 < ntiles) { const int nx = it + 1; const int kb = (nx < 4) ? qb * 256 + nx * 64 : (nx - 4) * 64;
            kreg = *(const v4u*)(kg + (size_t)kb * AW); vreg = *(const v4u*)(vg + (size_t)kb * AW); }
        const bool own = it < 4; const int t = it & 3, blk = (it - 4) >> 2;
        const bool mysel = own || ((sel >> blk) & 1u);
        const bool active = own ? (64 * t <= 32 * w + 31) : (__any(mysel ? 1 : 0) != 0);
        if (active) {
            const float pen = mysel ? 0.f : -INFINITY;
            f32x16 s0, s1;
#pragma unroll
            for (int r = 0; r < 16; ++r) { s0[r] = pen; s1[r] = pen; }
#pragma unroll
            for (int ds = 0; ds < 4; ++ds) {
                const bf16x8 a0 = *(const LAS bf16x8*)(kt + r32 * (AT_KROW * 2) + ds * 32 + hi * 16);
                const bf16x8 a1 = *(const LAS bf16x8*)(kt + (32 + r32) * (AT_KROW * 2) + ds * 32 + hi * 16);
                s0 = __builtin_amdgcn_mfma_f32_32x32x16_bf16(a0, qr[ds], s0, 0, 0, 0);
                s1 = __builtin_amdgcn_mfma_f32_32x32x16_bf16(a1, qr[ds], s1, 0, 0, 0);
            }
            if (own && 64 * t + 63 > 32 * w) {
#pragma unroll
                for (int r = 0; r < 16; ++r) { const int kv = 64 * t + crow(r, hi); if (kv > qrel) s0[r] = -INFINITY; if (kv + 32 > qrel) s1[r] = -INFINITY; }
            }
            float mx = fmaxf(s0[0], s1[0]);
#pragma unroll
            for (int r = 1; r < 16; ++r) mx = fmaxf(mx, fmaxf(s0[r], s1[r]));
            mx = fmaxf(mx, __shfl_xor(mx, 32));
            const float mnew = fmaxf(mrun, mx);
            const float f = __builtin_amdgcn_exp2f(mrun - mnew);
            mrun = mnew;
            float ps = 0.f;
#pragma unroll
            for (int r = 0; r < 16; ++r) { s0[r] = __builtin_amdgcn_exp2f(s0[r] - mnew); s1[r] = __builtin_amdgcn_exp2f(s1[r] - mnew); ps += s0[r] + s1[r]; }
            lrun = lrun * f + ps;
            if (__any(f != 1.0f ? 1 : 0)) {
#pragma unroll
                for (int r = 0; r < 16; ++r) { o0[r] *= f; o1[r] *= f; }
            }
            v4u pw[4];
            pw[0] = (v4u){pk2(s0[0], s0[1]), pk2(s0[2], s0[3]), pk2(s0[4], s0[5]), pk2(s0[6], s0[7])};
            pw[1] = (v4u){pk2(s0[8], s0[9]), pk2(s0[10], s0[11]), pk2(s0[12], s0[13]), pk2(s0[14], s0[15])};
            pw[2] = (v4u){pk2(s1[0], s1[1]), pk2(s1[2], s1[3]), pk2(s1[4], s1[5]), pk2(s1[6], s1[7])};
            pw[3] = (v4u){pk2(s1[8], s1[9]), pk2(s1[10], s1[11]), pk2(s1[12], s1[13]), pk2(s1[14], s1[15])};
#pragma unroll
            for (int j = 0; j < 4; ++j) {
                const bf16x8 pb = __builtin_bit_cast(bf16x8, pw[j]);
                { const LAS unsigned char* vp = vt + r32 * (AT_KROW * 2) + (16 * j + 4 * hi) * 2;
                  const s16x4 lo = *(const LAS s16x4*)vp, hh = *(const LAS s16x4*)(vp + 16);
                  const bf16x8 va = {lo[0], lo[1], lo[2], lo[3], hh[0], hh[1], hh[2], hh[3]};
                  o0 = __builtin_amdgcn_mfma_f32_32x32x16_bf16(va, pb, o0, 0, 0, 0); }
                { const LAS unsigned char* vp = vt + (32 + r32) * (AT_KROW * 2) + (16 * j + 4 * hi) * 2;
                  const s16x4 lo = *(const LAS s16x4*)vp, hh = *(const LAS s16x4*)(vp + 16);
                  const bf16x8 va = {lo[0], lo[1], lo[2], lo[3], hh[0], hh[1], hh[2], hh[3]};
                  o1 = __builtin_amdgcn_mfma_f32_32x32x16_bf16(va, pb, o1, 0, 0, 0); }
            }
        }
    }
    const float inv = 1.0f / (lrun + __shfl_xor(lrun, 32));
    bf16* op = O + (rowbase + qb * 256 + qrel) * AW + h * 64 + 4 * hi;
#pragma unroll
    for (int g = 0; g < 4; ++g) {
        v2u a; a.x = pk2(o0[4 * g] * inv, o0[4 * g + 1] * inv); a.y = pk2(o0[4 * g + 2] * inv, o0[4 * g + 3] * inv); *(v2u*)(op + 8 * g) = a;
        v2u c; c.x = pk2(o1[4 * g] * inv, o1[4 * g + 1] * inv); c.y = pk2(o1[4 * g + 2] * inv, o1[4 * g + 3] * inv); *(v2u*)(op + 32 + 8 * g) = c;
    }
    __syncthreads();
}

constexpr int SG_ROW = 136;
constexpr int SG_WAVE_BYTES = 64 * SG_ROW * 2, SG_RS = 8 * SG_WAVE_BYTES;
__device__ __forceinline__ void sgu_unit(int b, int ch, const bf16* U, const bf16* VS, bf16* O, const bf16* WS, const float* g_sgu, const float* b_sgu, LAS unsigned char* lds, int tid) {
    const int lane = tid & 63, g = __builtin_amdgcn_readfirstlane(tid >> 6), r32 = lane & 31, hi = lane >> 5;
    const size_t r0 = (size_t)b * SEQ + ch * 128;
    LAS float* rs = (LAS float*)(lds + SG_RS);
#pragma unroll 4
    for (int i = 0; i < 16; ++i) { const int t = 16 * g + i; const v4u v = *(const v4u*)(VS + (r0 + t) * SW + lane * 8);
        const float a0 = bf2f(v.x & 0xffff), a1 = bf2f(v.x >> 16), a2 = bf2f(v.y & 0xffff), a3 = bf2f(v.y >> 16), a4 = bf2f(v.z & 0xffff), a5 = bf2f(v.z >> 16), a6 = bf2f(v.w & 0xffff), a7 = bf2f(v.w >> 16);
        const float ss = wave_sum((a0 * a0 + a1 * a1) + (a2 * a2 + a3 * a3) + (a4 * a4 + a5 * a5) + (a6 * a6 + a7 * a7));
        if (lane == 0) rs[t] = 1.0f / sqrtf(ss * (1.0f / SW) + EPS); }
    __syncthreads();
    LAS unsigned short* vn = (LAS unsigned short*)(lds + g * SG_WAVE_BYTES);
#pragma unroll
    for (int dp = 0; dp < 4; ++dp) { const int d8 = (dp * 2 + hi) * 8;
        const f32x4 g0 = *(const f32x4*)(g_sgu + g * 64 + d8), g1 = *(const f32x4*)(g_sgu + g * 64 + d8 + 4);
#pragma unroll
        for (int sp = 0; sp < 4; ++sp) { const int s = sp * 32 + r32; const v4u v = *(const v4u*)(VS + (r0 + s) * SW + g * 64 + d8); const float rr = rs[s];
            LAS unsigned short* p = vn + d8 * SG_ROW + s;
            p[0 * SG_ROW] = (unsigned short)f2bf(bf2f(v.x & 0xffff) * rr * g0.x); p[1 * SG_ROW] = (unsigned short)f2bf(bf2f(v.x >> 16) * rr * g0.y);
            p[2 * SG_ROW] = (unsigned short)f2bf(bf2f(v.y & 0xffff) * rr * g0.z); p[3 * SG_ROW] = (unsigned short)f2bf(bf2f(v.y >> 16) * rr * g0.w);
            p[4 * SG_ROW] = (unsigned short)f2bf(bf2f(v.z & 0xffff) * rr * g1.x); p[5 * SG_ROW] = (unsigned short)f2bf(bf2f(v.z >> 16) * rr * g1.y);
            p[6 * SG_ROW] = (unsigned short)f2bf(bf2f(v.w & 0xffff) * rr * g1.z); p[7 * SG_ROW] = (unsigned short)f2bf(bf2f(v.w >> 16) * rr * g1.w); } }
    __syncthreads();
    const bf16* wg = WS + (size_t)g * 128 * 128;
#pragma unroll 1
    for (int tt = 0; tt < 4; ++tt) {
        f32x16 z0 = {}, z1 = {};
        const bf16* wrow = wg + (size_t)(32 * tt + r32) * 128 + hi * 8;
        for (int ks = 0; ks < 2 * tt + 2; ++ks) {
            const bf16x8 wb = *(const bf16x8*)(wrow + ks * 16);
            const bf16x8 a0 = *(const LAS bf16x8*)(vn + r32 * SG_ROW + ks * 16 + hi * 8);
            const bf16x8 a1 = *(const LAS bf16x8*)(vn + (32 + r32) * SG_ROW + ks * 16 + hi * 8);
            z0 = __builtin_amdgcn_mfma_f32_32x32x16_bf16(a0, wb, z0, 0, 0, 0);
            z1 = __builtin_amdgcn_mfma_f32_32x32x16_bf16(a1, wb, z1, 0, 0, 0);
        }
        const int t = 32 * tt + r32; const float bs = b_sgu[g * 128 + t];
        const size_t off = (r0 + t) * SW + g * 64 + 4 * hi;
#pragma unroll
        for (int q = 0; q < 4; ++q) {
            { const v2u uu = *(const v2u*)(U + off + 8 * q); v2u o;
              o.x = pk2(bf2f(uu.x & 0xffff) * (z0[4 * q] + bs), bf2f(uu.x >> 16) * (z0[4 * q + 1] + bs)); o.y = pk2(bf2f(uu.y & 0xffff) * (z0[4 * q + 2] + bs), bf2f(uu.y >> 16) * (z0[4 * q + 3] + bs));
              *(v2u*)(O + off + 8 * q) = o; }
            { const v2u uu = *(const v2u*)(U + off + 32 + 8 * q); v2u o;
              o.x = pk2(bf2f(uu.x & 0xffff) * (z1[4 * q] + bs), bf2f(uu.x >> 16) * (z1[4 * q + 1] + bs)); o.y = pk2(bf2f(uu.y & 0xffff) * (z1[4 * q + 2] + bs), bf2f(uu.y >> 16) * (z1[4 * q + 3] + bs));
              *(v2u*)(O + off + 32 + 8 * q) = o; }
        }
    }
    __syncthreads();
}

#define RLX_AGENT __ATOMIC_RELAXED, __HIP_MEMORY_SCOPE_AGENT
#define XB_TMO      128
#define XB_XCNT(j)  (256  + 64 * (j))
#define XB_XSUB(j)  (1280 + 64 * (j))
#define XB_XGEN(j)  (2304 + 64 * (j))
#define XB_TOP      3328
#define XB_TOPGEN   3392
#define XCD_BAR_WORDS 3456
#define XB_SPIN_CAP (1u << 18)

__device__ __forceinline__ unsigned xb_ld(unsigned* p)              { return __hip_atomic_load(p, __ATOMIC_RELAXED, __HIP_MEMORY_SCOPE_AGENT); }
__device__ __forceinline__ unsigned xb_add(unsigned* p, unsigned v) { return __hip_atomic_fetch_add(p, v, __ATOMIC_RELAXED, __HIP_MEMORY_SCOPE_AGENT); }
__device__ __forceinline__ unsigned xb_xcc_id() { return (unsigned)__builtin_amdgcn_s_getreg((3 << 11) | 20) & 0xFu; }
#define XB_SPIN(cond, bar) do { unsigned _sp = 0; while (cond) { __builtin_amdgcn_s_sleep(1); \
    if ((++_sp & 255u) == 0u) { if (xb_ld(&(bar)[XB_TMO])) break; if (_sp > XB_SPIN_CAP) { atomicAdd(&(bar)[XB_TMO], 1u); break; } } } } while (0)

struct XcdBarrier {
    unsigned* bar; unsigned x;
    volatile LAS unsigned* st;
};

__device__ __forceinline__ XcdBarrier xcd_barrier_post(unsigned* bar, volatile LAS unsigned* st) {
    XcdBarrier b; b.bar = bar; b.x = xb_xcc_id(); b.st = st;
    if (threadIdx.x == 0) (void)xb_add(&bar[XB_XCNT(b.x)], 1u);
    return b;
}
__device__ __forceinline__ void xcd_barrier_complete(unsigned* bar, unsigned x, unsigned& nloc, unsigned& nx) {
    const unsigned G = gridDim.x * gridDim.y * gridDim.z;
    unsigned sum, cnt, mine, sp = 0u;
    for (;;) {
        sum = 0u; cnt = 0u; mine = 0u;
#pragma unroll
        for (unsigned j = 0; j < 16; ++j) { const unsigned c = xb_ld(&bar[XB_XCNT(j)]); sum += c; cnt += (c > 0u) ? 1u : 0u; mine = (j == x) ? c : mine; }
        if (sum == G) break;
        __builtin_amdgcn_s_sleep(1);
        if ((++sp & 255u) == 0u) { if (xb_ld(&bar[XB_TMO])) break; if (sp > XB_SPIN_CAP) { atomicAdd(&bar[XB_TMO], 1u); break; } }
    }
    nloc = mine > 0u ? mine : 1u; nx = cnt > 0u ? cnt : 1u;
}

__device__ __forceinline__ void xcd_barrier(const XcdBarrier& b) {
    asm volatile("s_waitcnt vmcnt(0)" ::: "memory");
    __syncthreads();
    if (threadIdx.x == 0) {
        unsigned* bar = b.bar;
        __builtin_amdgcn_s_waitcnt(0);
        unsigned nloc = b.st[0], nx = b.st[1];
        if (nloc == 0u) { xcd_barrier_complete(bar, b.x, nloc, nx); b.st[0] = nloc; b.st[1] = nx; }
        const unsigned old = xb_add(&bar[XB_XSUB(b.x)], 1u);
        const unsigned gen = old / nloc;
        if (old + 1u == (gen + 1u) * nloc) {
            __builtin_amdgcn_fence(__ATOMIC_RELEASE, "agent");
            asm volatile("s_waitcnt vmcnt(0)" ::: "memory");
            const unsigned og = xb_add(&bar[XB_TOP], 1u);
            const unsigned tg = og / nx;
            if (og + 1u == (tg + 1u) * nx) xb_add(&bar[XB_TOPGEN], 1u);
            else XB_SPIN(xb_ld(&bar[XB_TOPGEN]) == tg, bar);
            __builtin_amdgcn_fence(__ATOMIC_ACQUIRE, "agent");
            xb_add(&bar[XB_XGEN(b.x)], 1u);
            asm volatile("s_waitcnt vmcnt(0)" ::: "memory");
        } else {
            XB_SPIN(xb_ld(&bar[XB_XGEN(b.x)]) == gen, bar);
            __builtin_amdgcn_fence(__ATOMIC_ACQUIRE, "agent");
            asm volatile("s_waitcnt vmcnt(0)" ::: "memory");
        }
    }
    __syncthreads();
}

struct Args { const float* in[16]; float* out; unsigned char* ws; };

__global__ void __launch_bounds__(NWAVES * 64, 2) moba_gmlp_fwd(Args a) {
    extern __shared__ __attribute__((aligned(16))) unsigned char lds_raw[];
    cg::grid_group grid = cg::this_grid();
    LAS unsigned char* lds = (LAS unsigned char*)lds_raw;
    const int tid = threadIdx.x, lane = tid & 63, wave = __builtin_amdgcn_readfirstlane(tid >> 6);
    const int G = gridDim.x, bx = blockIdx.x;
    const int gw = bx * NWAVES + wave, NGW = G * NWAVES;
    const float *x = a.in[0], *c = a.in[1], *w_ada = a.in[2], *b_ada = a.in[3], *g_mix = a.in[4], *w_in = a.in[5], *w_pa = a.in[6], *g_sgu = a.in[7], *w_sgu = a.in[8], *b_sgu = a.in[9],
                *w_ps = a.in[10], *w_out = a.in[11], *g_ffn = a.in[12], *w_ff1 = a.in[13], *w_ff2 = a.in[14], *g_final = a.in[15];
    unsigned char* ws = a.ws; float* out = a.out;
    float* MOD = (float*)(ws + WS_MOD); float* KSUM = (float*)(ws + WS_KSUM);
    bf16 *WSG = (bf16*)(ws + WS_WSGU), *WIN = (bf16*)(ws + WS_WIN), *WPA = (bf16*)(ws + WS_WPA), *WPS = (bf16*)(ws + WS_WPS), *WOUT = (bf16*)(ws + WS_WOUT), *WFF1 = (bf16*)(ws + WS_WFF1), *WFF2 = (bf16*)(ws + WS_WFF2);
    bf16 *Hb = (bf16*)(ws + WS_H), *Qb = (bf16*)(ws + WS_Q), *Kb = (bf16*)(ws + WS_K), *Vb = (bf16*)(ws + WS_V), *Ub = (bf16*)(ws + WS_U), *VSb = (bf16*)(ws + WS_VS), *GAb = (bf16*)(ws + WS_GA), *GBb = (bf16*)(ws + WS_GB),
         *ATTO = (bf16*)(ws + WS_ATTO), *SGUO = (bf16*)(ws + WS_SGUO), *HID = (bf16*)(ws + WS_HID);

    volatile LAS unsigned* MISC = (volatile LAS unsigned*)(lds + LDS_BYTES - 64);
    unsigned* barw = (unsigned*)ws;
    if (tid < 16) MISC[tid] = 0u;
    if (bx == 0) { for (int i = tid; i < XCD_BAR_WORDS; i += NWAVES * 64) barw[i] = 0u; __threadfence(); }
    __syncthreads();
    for (int it = bx; it < NMODW / 32; it += G) mod_item(c, w_ada, b_ada, MOD, it, lds, tid);
    {
        LAS float* scr = (LAS float*)(lds + wave * 16384);
        constexpr int I_IN = (DM / 64) * (INW / 32), I_PA = (AW / 64) * (DM / 32), I_PS = (SW / 64) * (DM / 32), I_OUT = (DM / 64) * (DM / 32), I_F1 = (DM / 64) * (DFF / 32), I_F2 = (DFF / 64) * (DM / 32);
        constexpr int NITEMS = I_IN + I_PA + I_PS + I_OUT + I_F1 + I_F2;
        for (int it = gw; it < NITEMS; it += NGW) {
            int r = it;
            if (r < I_IN) { transpose_item(w_in, DM, INW, WIN, scr, r, lane); continue; } r -= I_IN;
            if (r < I_PA) { transpose_item(w_pa, AW, DM, WPA, scr, r, lane); continue; } r -= I_PA;
            if (r < I_PS) { transpose_item(w_ps, SW, DM, WPS, scr, r, lane); continue; } r -= I_PS;
            if (r < I_OUT) { transpose_item(w_out, DM, DM, WOUT, scr, r, lane); continue; } r -= I_OUT;
            if (r < I_F1) { transpose_item(w_ff1, DM, DFF, WFF1, scr, r, lane); continue; } r -= I_F1;
            transpose_item(w_ff2, DFF, DM, WFF2, scr, r, lane);
        }
        for (int i = bx * 512 + tid; i < 8 * 128 * 128; i += G * 512) { const int s = i & 127, t = (i >> 7) & 127; WSG[i] = (unsigned short)f2bf(s <= t ? w_sgu[i] : 0.f); }
    }
    grid.sync();
    const XcdBarrier xb = xcd_barrier_post(barw, MISC);
    norm_rows_bf16(x, Hb, g_mix, MOD, 0, DM, gw, NGW, lane);
    xcd_barrier(xb);
    { pg8::Gemm g{Hb, WIN, M, INW, DM}; pg8::StaticOrder S; S.init(M, INW, G, bx); pg8::EpiIn E{Qb, KSUM};
      pg8::gemm_phase<pg8::EpiIn, pg8::StaticOrder, true, true>(lds, g, S, E); }
    xcd_barrier(xb);
    for (int u = bx; u < BATCH * 8; u += G) {
        const int b = u >> 3, h = u & 7;
        for (int qb = 7; qb >= 0; --qb) attn_unit(b, h, qb, Qb, Kb, Vb, ATTO, KSUM, lds, tid);
    }
    for (int u = bx; u < BATCH * 16; u += G) sgu_unit(u >> 4, u & 15, Ub, VSb, SGUO, WSG, g_sgu, b_sgu, lds, tid);
    xcd_barrier(xb);
    { pg8::Gemm g{ATTO, WPA, M, DM, AW}; pg8::StaticOrder S; S.init(M, DM, G, bx); pg8::EpiMul<0> E{GAb, nullptr};
      pg8::gemm_phase<pg8::EpiMul<0>, pg8::StaticOrder, true, true>(lds, g, S, E); }
    { pg8::Gemm g{SGUO, WPS, M, DM, SW}; pg8::StaticOrder S; S.init(M, DM, G, bx); pg8::EpiMul<1> E{GAb, GBb};
      pg8::gemm_phase<pg8::EpiMul<1>, pg8::StaticOrder, true, true>(lds, g, S, E); }
    xcd_barrier(xb);
    { pg8::Gemm g{GAb, WOUT, M, DM, DM}; pg8::StaticOrder S; S.init(M, DM, G, bx); pg8::EpiRes E{x, out, MOD + 2 * DM};
      pg8::gemm_phase<pg8::EpiRes, pg8::StaticOrder, true, true>(lds, g, S, E); }
    xcd_barrier(xb);
    norm_rows_bf16(out, Hb, g_ffn, MOD, 3 * DM, 4 * DM, gw, NGW, lane);
    xcd_barrier(xb);
    { pg8::Gemm g{Hb, WFF1, M, DFF, DM}; pg8::StaticOrder S; S.init(M, DFF, G, bx); pg8::EpiRelu2 E{HID};
      pg8::gemm_phase<pg8::EpiRelu2, pg8::StaticOrder, true, true>(lds, g, S, E); }
    xcd_barrier(xb);
    { pg8::Gemm g{HID, WFF2, M, DM, DFF}; pg8::StaticOrder S; S.init(M, DM, G, bx); pg8::EpiRes E{out, out, MOD + 5 * DM};
      pg8::gemm_phase<pg8::EpiRes, pg8::StaticOrder, true, true>(lds, g, S, E); }
    xcd_barrier(xb);
    norm_rows_final(out, g_final, gw, NGW, lane);
}

extern "C" void kernel_launch(void* const* d_in, const int* in_sizes, int n_in, void* d_out, int out_size, void* d_ws, size_t ws_size, hipStream_t stream) {
    static int grid = 0;
    if (grid == 0) {
        if (n_in != 16 || in_sizes[0] != M * DM || out_size != M * DM || ws_size < WS_END) { fprintf(stderr, "kernel_launch: unexpected shapes / workspace (n_in %d, in0 %d, out %d, ws %zu); nothing launched\n", n_in, n_in > 0 ? in_sizes[0] : -1, out_size, ws_size); grid = -1; return; }
        int dev = 0, cus = 0, per_cu = 0;
        hipGetDevice(&dev); hipDeviceGetAttribute(&cus, hipDeviceAttributeMultiprocessorCount, dev);
        if (hipFuncSetAttribute((const void*)moba_gmlp_fwd, hipFuncAttributeMaxDynamicSharedMemorySize, LDS_BYTES) != hipSuccess) { fprintf(stderr, "kernel_launch: hipFuncSetAttribute failed\n"); grid = -1; return; }
        if (hipOccupancyMaxActiveBlocksPerMultiprocessor(&per_cu, (const void*)moba_gmlp_fwd, NWAVES * 64, LDS_BYTES) != hipSuccess || per_cu < 1) { fprintf(stderr, "kernel_launch: occupancy query says %d blocks per CU\n", per_cu); (void)hipGetLastError(); grid = -1; return; }
        grid = cus * 1;
    }
    if (grid < 0) return;
    Args a{};
    for (int i = 0; i < 16; ++i) a.in[i] = (const float*)d_in[i];
    a.out = (float*)d_out; a.ws = (unsigned char*)d_ws;
    void* args[] = {&a};
    hipError_t e = hipLaunchCooperativeKernel((const void*)moba_gmlp_fwd, dim3(grid), dim3(NWAVES * 64), args, LDS_BYTES, stream);
    if (e != hipSuccess) fprintf(stderr, "cooperative launch failed: %s (grid %d)\n", hipGetErrorString(e), grid);
}
```
